# Optimizing an MI355X kernel written in HIP

```python
import jax
import jax.numpy as jnp
from jax import lax
import numpy as np

D_MODEL = 1024
BATCH = 32
SEQ = 2048
DEPTH = 2

GRID_W = 64
CTX_LEN = 256
NORM_EPS = 1e-6

MLA_HEADS = 8
MLA_Q_RANK = 256
MLA_KV_RANK = 128
MLA_NOPE = 64
MLA_ROPE = 32
MLA_V = 64
MLA_WIDTH = MLA_HEADS * MLA_V
ROPE_BASE = 10000.0
Q_BLOCK = 128

POOL_WINDOWS = (2, 4, 8, 16)
POOL_WIDTH = 512
POOL_GROUP = POOL_WIDTH // len(POOL_WINDOWS)

GLA_HEADS = 4
GLA_DK = 64
GLA_DV = 128
GLA_KW = GLA_HEADS * GLA_DK
GLA_WIDTH = GLA_HEADS * GLA_DV
GLA_GATE_RANK = 16
GLA_TAU = 16.0
GLA_CHUNK = 64

N_BRANCH = 3

IN_NAMES = ('mla_q', 'mla_kv', 'mla_kr', 'mla_gate', 'pool_x', 'pool_gate',
            'gla_q', 'gla_k', 'gla_v', 'gla_af', 'gla_ab', 'gla_gate', 'merge')
IN_SIZES = (MLA_Q_RANK, MLA_KV_RANK, MLA_ROPE, MLA_WIDTH, POOL_WIDTH, POOL_WIDTH,
            GLA_KW, GLA_KW, GLA_WIDTH, GLA_GATE_RANK, GLA_GATE_RANK, GLA_WIDTH, N_BRANCH * D_MODEL)
D_IN = sum(IN_SIZES)

kernel_name = 'hybrid_mla_pool_gla_prefix_dit'


def rmsnorm(x, g):
    xf = x.astype(jnp.float32)
    y = xf * lax.rsqrt(jnp.mean(xf * xf, axis=-1, keepdims=True) + NORM_EPS)
    return (y * g.astype(jnp.float32)).astype(x.dtype)


def split_columns(z):
    offsets = [int(o) for o in np.cumsum(IN_SIZES)[:-1]]
    return dict(zip(IN_NAMES, jnp.split(z, offsets, axis=-1)))


def flip(t):
    return t[:, ::-1]


def axial_rope_tables(row, col):
    half = MLA_ROPE // 2
    inv = ROPE_BASE ** (-jnp.arange(0, half, 2, dtype=jnp.float32) / half)
    ang_r = row.astype(jnp.float32)[:, None] * inv
    ang_c = col.astype(jnp.float32)[:, None] * inv
    ang = jnp.concatenate([ang_r, ang_r, ang_c, ang_c], axis=-1)
    return jnp.cos(ang), jnp.sin(ang)


def apply_rope(x, cos, sin):
    half = MLA_ROPE // 2
    quarter = half // 2

    def rot(v):
        return jnp.concatenate([-v[..., quarter:], v[..., :quarter]], axis=-1)

    rotated = jnp.concatenate([rot(x[..., :half]), rot(x[..., half:])], axis=-1)
    return (x * cos + rotated * sin).astype(x.dtype)


def softmax_attention(q, k, v, scale):
    s = jnp.einsum('bqhd,bkhd->bhqk', q, k).astype(jnp.float32) * scale
    p = jax.nn.softmax(s, axis=-1).astype(v.dtype)
    return jnp.einsum('bhqk,bkhd->bqhd', p, v)


def blocked_attention(q, k, v, scale):
    B, L, H, dk = q.shape
    nblk = L // Q_BLOCK
    qb = q.reshape(B, nblk, Q_BLOCK, H, dk).transpose(1, 0, 2, 3, 4)
    ob = lax.map(lambda qq: softmax_attention(qq, k, v, scale), qb)
    return ob.transpose(1, 0, 2, 3, 4).reshape(B, L, H, v.shape[-1])


def mla_queries(zz, q_norm, w_uq):
    B, L, _ = zz['mla_q'].shape
    q = (rmsnorm(zz['mla_q'], q_norm) @ w_uq).reshape(B, L, MLA_HEADS, MLA_NOPE + MLA_ROPE)
    return q[..., :MLA_NOPE], q[..., MLA_NOPE:]


def mla_keys_values(zz, kv_norm, w_ukv):
    B, L, _ = zz['mla_kv'].shape
    kv = (rmsnorm(zz['mla_kv'], kv_norm) @ w_ukv).reshape(B, L, MLA_HEADS, MLA_NOPE + MLA_V)
    return kv[..., :MLA_NOPE], kv[..., MLA_NOPE:]


def assemble_keys(k_nope, k_rope):
    B, L, H, _ = k_nope.shape
    return jnp.concatenate([k_nope, jnp.broadcast_to(k_rope[:, :, None, :], (B, L, H, MLA_ROPE))], axis=-1)


def mla_branch(z, zc, cos, sin, q_norm, w_uq, kv_norm, w_ukv, with_ctx_out):
    B, L, _ = z['mla_q'].shape
    scale = (MLA_NOPE + MLA_ROPE) ** -0.5
    q_nope, q_rope = mla_queries(z, q_norm, w_uq)
    q = jnp.concatenate([q_nope, apply_rope(q_rope, cos[:, None, :], sin[:, None, :])], axis=-1)
    k_nope, v = mla_keys_values(z, kv_norm, w_ukv)
    k = assemble_keys(k_nope, apply_rope(z['mla_kr'], cos, sin))
    kc_nope, vc = mla_keys_values(zc, kv_norm, w_ukv)
    kc = assemble_keys(kc_nope, zc['mla_kr'])
    k_all = jnp.concatenate([kc, k], axis=1)
    v_all = jnp.concatenate([vc, v], axis=1)
    y = blocked_attention(q, k_all, v_all, scale).reshape(B, L, MLA_WIDTH)
    y = y * jax.nn.silu(z['mla_gate'])
    if with_ctx_out:
        Bc, Lc, _ = zc['mla_q'].shape
        qc = jnp.concatenate(mla_queries(zc, q_norm, w_uq), axis=-1)
        yc = softmax_attention(qc, kc, vc, scale).reshape(Bc, Lc, MLA_WIDTH) * jax.nn.silu(zc['mla_gate'])
    else:
        yc = None
    return y, yc


def multiscale_pool(u):
    B, L, W = u.shape
    uf = u.astype(jnp.float32)
    csum = jnp.concatenate([jnp.zeros((B, 1, W), jnp.float32), jnp.cumsum(uf, axis=1)], axis=1)
    t = jnp.arange(L)
    outs = []
    for g, w in enumerate(POOL_WINDOWS):
        lo = jnp.clip(t - w // 2, 0, L)
        hi = jnp.clip(t + w // 2, 0, L)
        cs = csum[..., g * POOL_GROUP:(g + 1) * POOL_GROUP]
        count = (hi - lo).astype(jnp.float32)[None, :, None]
        outs.append((jnp.take(cs, hi, axis=1) - jnp.take(cs, lo, axis=1)) / count)
    return (jnp.concatenate(outs, axis=-1) - uf).astype(u.dtype)


def pool_branch(zz, pool_w, pool_scale):
    B, L, _ = zz['pool_x'].shape
    pooled = multiscale_pool(zz['pool_x']).reshape(B, L, len(POOL_WINDOWS), POOL_GROUP)
    mixed = jnp.einsum('blgi,gio->blgo', pooled, pool_w).reshape(B, L, POOL_WIDTH)
    return mixed * pool_scale * jax.nn.silu(zz['pool_gate'])


def gla_scan(q, k, v, log_a, s0, with_out):
    B, L, H, _ = q.shape
    n = L // GLA_CHUNK

    def to_chunks(t):
        return t.reshape(B, n, GLA_CHUNK, H, t.shape[-1]).transpose(1, 0, 3, 2, 4)

    mask = jnp.tril(jnp.ones((GLA_CHUNK, GLA_CHUNK), bool))[:, :, None]

    def step(s, inp):
        qq, kk, vv, aa = inp
        b = jnp.cumsum(aa, axis=2)
        b_last = b[:, :, -1:, :]
        s_new = jnp.exp(b_last)[:, :, 0, :, None] * s + jnp.einsum('bhcd,bhce->bhde', kk * jnp.exp(b_last - b), vv)
        if not with_out:
            return s_new, None
        inter = jnp.einsum('bhcd,bhde->bhce', qq * jnp.exp(b), s)
        decay = jnp.exp(jnp.where(mask, b[:, :, :, None, :] - b[:, :, None, :, :], -jnp.inf))
        attn = jnp.einsum('bhid,bhjd,bhijd->bhij', qq, kk, decay)
        intra = jnp.einsum('bhij,bhje->bhie', attn, vv)
        return s_new, inter + intra

    s_fin, out = lax.scan(step, s0, (to_chunks(q), to_chunks(k), to_chunks(v), to_chunks(log_a)))
    if with_out:
        out = out.transpose(1, 0, 3, 2, 4).reshape(B, L, H, v.shape[-1])
    return s_fin, out


def gla_inputs(zz, af_w2, af_b, ab_w2, ab_b):
    B, L, _ = zz['gla_v'].shape
    f32 = jnp.float32
    q = zz['gla_q'].astype(f32).reshape(B, L, GLA_HEADS, GLA_DK) * GLA_DK ** -0.5
    k = zz['gla_k'].astype(f32).reshape(B, L, GLA_HEADS, GLA_DK)
    v = zz['gla_v'].astype(f32).reshape(B, L, GLA_HEADS, GLA_DV)
    log_a_f = (jax.nn.log_sigmoid((zz['gla_af'] @ af_w2 + af_b).astype(f32)) / GLA_TAU).reshape(B, L, GLA_HEADS, GLA_DK)
    log_a_b = (jax.nn.log_sigmoid((zz['gla_ab'] @ ab_w2 + ab_b).astype(f32)) / GLA_TAU).reshape(B, L, GLA_HEADS, GLA_DK)
    return q, k, v, log_a_f, log_a_b


def gla_output(o, zz, g):
    B, L = o.shape[:2]
    o = rmsnorm(o, g).reshape(B, L, GLA_WIDTH).astype(zz['gla_gate'].dtype)
    return o * jax.nn.silu(zz['gla_gate'])


def gla_branch(z, zc, af_w2, af_b, ab_w2, ab_b, gla_norm, with_ctx_out):
    qc, kc, vc, afc, abc = gla_inputs(zc, af_w2, af_b, ab_w2, ab_b)
    s0 = jnp.zeros((qc.shape[0], GLA_HEADS, GLA_DK, GLA_DV), jnp.float32)
    sc_f, oc_f = gla_scan(qc, kc, vc, afc, s0, with_ctx_out)
    sc_b, oc_b = gla_scan(flip(qc), flip(kc), flip(vc), flip(abc), s0, with_ctx_out)
    q, k, v, af, ab = gla_inputs(z, af_w2, af_b, ab_w2, ab_b)
    _, o_f = gla_scan(q, k, v, af, sc_f, True)
    _, o_b = gla_scan(flip(q), flip(k), flip(v), flip(ab), sc_b, True)
    y = gla_output(o_f + flip(o_b), z, gla_norm)
    yc = gla_output(oc_f + flip(oc_b), zc, gla_norm) if with_ctx_out else None
    return y, yc


def merge_branches(zz, y_mla, y_pool, y_gla, w_bm, w_bp, w_bg, w_out):
    gates = jax.nn.sigmoid(zz['merge'].astype(jnp.float32)).astype(y_mla.dtype)
    g_mla, g_pool, g_gla = jnp.split(gates, N_BRANCH, axis=-1)
    merged = g_mla * (y_mla @ w_bm) + g_pool * (y_pool @ w_bp) + g_gla * (y_gla @ w_bg)
    return merged @ w_out


def trunk_layer(x, xc, mod, mod_c, cos, sin, pre_g, post_g, w_in, mla_q_norm, mla_w_uq, mla_kv_norm,
                mla_w_ukv, pool_w, pool_scale, gla_af_w2, gla_af_b, gla_ab_w2, gla_ab_b, gla_norm,
                w_branch_mla, w_branch_pool, w_branch_gla, w_out, with_ctx_out):
    shift, scale, gate = jnp.split(mod[:, None, :], 3, axis=-1)
    shift_c, scale_c, gate_c = jnp.split(mod_c[None, None, :], 3, axis=-1)
    z = split_columns((rmsnorm(x, pre_g) * (1 + scale) + shift) @ w_in)
    zc = split_columns((rmsnorm(xc, pre_g) * (1 + scale_c) + shift_c) @ w_in)
    y_mla, yc_mla = mla_branch(z, zc, cos, sin, mla_q_norm, mla_w_uq, mla_kv_norm, mla_w_ukv, with_ctx_out)
    y_pool = pool_branch(z, pool_w, pool_scale)
    y_gla, yc_gla = gla_branch(z, zc, gla_af_w2, gla_af_b, gla_ab_w2, gla_ab_b, gla_norm, with_ctx_out)
    out = merge_branches(z, y_mla, y_pool, y_gla, w_branch_mla, w_branch_pool, w_branch_gla, w_out)
    x = x + gate * rmsnorm(out, post_g)
    if with_ctx_out:
        yc_pool = pool_branch(zc, pool_w, pool_scale)
        out_c = merge_branches(zc, yc_mla, yc_pool, yc_gla, w_branch_mla, w_branch_pool, w_branch_gla, w_out)
        xc = xc + gate_c * rmsnorm(out_c, post_g)
    return x, xc


def setup_inputs(seed: int = 0) -> dict:
    key = jax.random.key(seed)
    ks = jax.random.split(key, 24)
    f32 = jnp.float32

    def nrm(k, shape, s):
        return jax.random.normal(k, shape, f32) * s

    def gain(k, n):
        return 1.0 + 0.1 * jax.random.normal(k, (DEPTH, n), f32)

    return {
        'x': nrm(ks[0], (BATCH, SEQ, D_MODEL), 1.0),
        'c': nrm(ks[1], (BATCH, D_MODEL), 1.0),
        'ctx': nrm(ks[2], (BATCH, CTX_LEN, D_MODEL), 1.0),
        'c_ctx': nrm(ks[3], (D_MODEL,), 1.0),
        'mod_w': nrm(ks[4], (DEPTH, D_MODEL, 3 * D_MODEL), 0.5 * D_MODEL ** -0.5),
        'mod_b': nrm(ks[5], (DEPTH, 3 * D_MODEL), 0.02),
        'pre_norm': gain(ks[6], D_MODEL),
        'post_norm': gain(ks[7], D_MODEL),
        'w_in': nrm(ks[8], (DEPTH, D_MODEL, D_IN), D_MODEL ** -0.5),
        'mla_q_norm': gain(ks[9], MLA_Q_RANK),
        'mla_w_uq': nrm(ks[10], (DEPTH, MLA_Q_RANK, MLA_HEADS * (MLA_NOPE + MLA_ROPE)), MLA_Q_RANK ** -0.5),
        'mla_kv_norm': gain(ks[11], MLA_KV_RANK),
        'mla_w_ukv': nrm(ks[12], (DEPTH, MLA_KV_RANK, MLA_HEADS * (MLA_NOPE + MLA_V)), MLA_KV_RANK ** -0.5),
        'pool_w': nrm(ks[13], (DEPTH, len(POOL_WINDOWS), POOL_GROUP, POOL_GROUP), POOL_GROUP ** -0.5),
        'pool_scale': gain(ks[14], POOL_WIDTH),
        'gla_af_w2': nrm(ks[15], (DEPTH, GLA_GATE_RANK, GLA_KW), GLA_GATE_RANK ** -0.5),
        'gla_af_b': nrm(ks[16], (DEPTH, GLA_KW), 0.1),
        'gla_ab_w2': nrm(ks[17], (DEPTH, GLA_GATE_RANK, GLA_KW), GLA_GATE_RANK ** -0.5),
        'gla_ab_b': nrm(ks[18], (DEPTH, GLA_KW), 0.1),
        'gla_norm': gain(ks[19], GLA_DV),
        'w_branch_mla': nrm(ks[20], (DEPTH, MLA_WIDTH, D_MODEL), MLA_WIDTH ** -0.5),
        'w_branch_pool': nrm(ks[21], (DEPTH, POOL_WIDTH, D_MODEL), POOL_WIDTH ** -0.5),
        'w_branch_gla': nrm(ks[22], (DEPTH, GLA_WIDTH, D_MODEL), GLA_WIDTH ** -0.5),
        'w_out': nrm(ks[23], (DEPTH, D_MODEL, D_MODEL), D_MODEL ** -0.5),
    }


def reference(x, c, ctx, c_ctx, mod_w, mod_b, pre_norm, post_norm, w_in, mla_q_norm, mla_w_uq,
              mla_kv_norm, mla_w_ukv, pool_w, pool_scale, gla_af_w2, gla_af_b, gla_ab_w2, gla_ab_b,
              gla_norm, w_branch_mla, w_branch_pool, w_branch_gla, w_out):
    n_tok = x.shape[1]
    rows = n_tok // GRID_W
    row = jnp.repeat(jnp.arange(rows), GRID_W)
    col = jnp.tile(jnp.arange(GRID_W), rows)
    cos, sin = axial_rope_tables(row, col)
    silu_c = jax.nn.silu(c)
    silu_cc = jax.nn.silu(c_ctx)
    xc = ctx
    for l in range(DEPTH):
        mod = silu_c @ mod_w[l] + mod_b[l]
        mod_c = silu_cc @ mod_w[l] + mod_b[l]
        x, xc = trunk_layer(x, xc, mod, mod_c, cos, sin, pre_norm[l], post_norm[l], w_in[l],
                            mla_q_norm[l], mla_w_uq[l], mla_kv_norm[l], mla_w_ukv[l], pool_w[l],
                            pool_scale[l], gla_af_w2[l], gla_af_b[l], gla_ab_w2[l], gla_ab_b[l],
                            gla_norm[l], w_branch_mla[l], w_branch_pool[l], w_branch_gla[l], w_out[l],
                            l < DEPTH - 1)
    return x
```

```cpp
#include <hip/hip_runtime.h>
#include <hip/hip_cooperative_groups.h>
#include <cstdio>
#include <cstdint>
namespace cg = cooperative_groups;

#define LAS __attribute__((address_space(3)))
typedef unsigned short bf16_t;
typedef short bf16x8 __attribute__((ext_vector_type(8)));
typedef short s16x4 __attribute__((ext_vector_type(4)));
typedef float f32x4 __attribute__((ext_vector_type(4)));
typedef float f32x2 __attribute__((ext_vector_type(2)));
typedef float f32x16 __attribute__((ext_vector_type(16)));
typedef unsigned u32x4 __attribute__((ext_vector_type(4)));
typedef unsigned u32x2 __attribute__((ext_vector_type(2)));
typedef __bf16 bf16x2_t __attribute__((ext_vector_type(2)));

constexpr int NB = 32, SEQ = 2048, CTXL = 256, TOK = 2304, M = NB * TOK, D = 1024, DIN = 6592, ZP = 3584;
constexpr int ZQ = 0, ZKV = 256, ZPX = 512, ZGQ = 1024, ZGK = 1280, ZGV = 1536, ZYM = 2048, ZYP = 2560, ZYG = 3072;
constexpr int ZAF = ZKV + 192, ZAB = ZKV + 208;
constexpr float EPS = 1e-6f;
constexpr float QSCALE = 0.10206207261596577f * 1.4426950408889634f;
constexpr int C_MQ = 0, C_MKV = 256, C_MKR = 384, C_MG = 416, C_PX = 928, C_PG = 1440, C_GQ = 1952, C_GK = 2208, C_GV = 2464, C_AF = 2976, C_AB = 2992, C_GG = 3008, C_MRG = 3520;

constexpr size_t SZ_Z = (size_t)M * ZP * 2, SZ_H = (size_t)M * D * 2, SZ_Q = (size_t)M * 768 * 2, SZ_KV = (size_t)M * 1024 * 2, SZ_OT = (size_t)M * 512 * 2, SZ_KR = (size_t)M * 32 * 2;
constexpr size_t OFF_Z = 0, OFF_H = OFF_Z + SZ_Z, OFF_Q = OFF_H + SZ_H, OFF_KV = OFF_Q + SZ_Q, OFF_OT = OFF_KV + SZ_KV, OFF_KR = OFF_OT + SZ_OT, OFF_W = OFF_KR + SZ_KR;
constexpr size_t W_IN = 0, W_M = W_IN + 3584 * 1024 * 2, W_UQ = W_M + 3072 * 1024 * 2, W_UKV = W_UQ + 1024 * 256 * 2, W_BR = W_UKV + 1024 * 256 * 2, W_OUT = W_BR + 1024 * 1536 * 2, W_POOL = W_OUT + 1024 * 1024 * 2, W_LAYER = W_POOL + 4 * 128 * 128 * 2;
constexpr size_t OFF_SSQQ = OFF_W + 2 * W_LAYER, OFF_SSQKV = OFF_SSQQ + (size_t)M * 4, OFF_MOD = OFF_SSQKV + (size_t)M * 4, OFF_TAB = OFF_MOD + 2 * 33 * 3072 * 4, OFF_BAR = OFF_TAB + 64 * 8 * 8, WS_END = OFF_BAR + 16384;
constexpr size_t GSCR_PER_WG = 3 * 16 * 512 * 16;
static_assert(256 * GSCR_PER_WG <= SZ_Q, "gate scratch overlays Q");
static_assert(WS_END <= (size_t)1 << 30, "workspace");

constexpr int LDS_BYTES = 147456;
#ifndef DUP
#define DUP 0
#endif

__device__ __forceinline__ unsigned cvtpk(float lo, float hi) { f32x2 v = {lo, hi}; bf16x2_t b = __builtin_convertvector(v, bf16x2_t); return __builtin_bit_cast(unsigned, b); }
__device__ __forceinline__ bf16_t f2bf(float f) { return (bf16_t)(cvtpk(f, 0.f) & 0xffffu); }
__device__ __forceinline__ float bf2f(bf16_t b) { return __uint_as_float(((unsigned)b) << 16); }
__device__ __forceinline__ float bflo(unsigned u) { return __uint_as_float(u << 16); }
__device__ __forceinline__ float bfhi(unsigned u) { return __uint_as_float(u & 0xffff0000u); }
__device__ __forceinline__ float fexp2(float x) { return __builtin_amdgcn_exp2f(x); }
__device__ __forceinline__ float fexp(float x) { return __builtin_amdgcn_exp2f(x * 1.4426950408889634f); }
__device__ __forceinline__ float frcp(float x) { return __builtin_amdgcn_rcpf(x); }
__device__ __forceinline__ float sigmoidf_(float x) { return frcp(1.f + fexp(-x)); }
__device__ __forceinline__ float siluf_(float x) { return x * sigmoidf_(x); }
__device__ __forceinline__ float wave_sum(float v) {
#pragma unroll
    for (int o = 1; o < 64; o <<= 1) v += __shfl_xor(v, o);
    return v;
}
__device__ __forceinline__ int crow(int r, int hi) { return (r & 3) + 8 * (r >> 2) + 4 * hi; }
__device__ __forceinline__ u32x4 pack8(f32x4 a, f32x4 b) { u32x4 o; o.x = cvtpk(a[0], a[1]); o.y = cvtpk(a[2], a[3]); o.z = cvtpk(b[0], b[1]); o.w = cvtpk(b[2], b[3]); return o; }
__device__ __forceinline__ s16x4 trread(const LAS char* p) { return __builtin_bit_cast(s16x4, __builtin_amdgcn_ds_read_tr16_b64_v4i16((LAS s16x4*)p)); }
#define MK8(lo, hi) (bf16x8){lo[0], lo[1], lo[2], lo[3], hi[0], hi[1], hi[2], hi[3]}


#define XB_TMO      128
#define XB_XCNT(j)  (256  + 64 * (j))
#define XB_XSUB(j)  (1280 + 64 * (j))
#define XB_XGEN(j)  (2304 + 64 * (j))
#define XB_TOP      3328
#define XB_TOPGEN   3392
#define XCD_BAR_WORDS 3456
#define XB_SPIN_CAP (1u << 18)
__device__ __forceinline__ unsigned xb_ld(unsigned* p)              { return __hip_atomic_load(p, __ATOMIC_RELAXED, __HIP_MEMORY_SCOPE_AGENT); }
__device__ __forceinline__ unsigned xb_add(unsigned* p, unsigned v) { return __hip_atomic_fetch_add(p, v, __ATOMIC_RELAXED, __HIP_MEMORY_SCOPE_AGENT); }
__device__ __forceinline__ unsigned xb_xcc_id() { return (unsigned)__builtin_amdgcn_s_getreg((3 << 11) | 20) & 0xFu; }
#define XB_SPIN(cond, bar) do { unsigned _sp = 0; while (cond) { __builtin_amdgcn_s_sleep(1); \
    if ((++_sp & 255u) == 0u) { if (xb_ld(&(bar)[XB_TMO])) break; if (_sp > XB_SPIN_CAP) { atomicAdd(&(bar)[XB_TMO], 1u); break; } } } } while (0)
struct XcdBarrier { unsigned* bar; unsigned x; volatile LAS unsigned* st; };
__device__ __forceinline__ XcdBarrier xcd_barrier_post(unsigned* bar, volatile LAS unsigned* st) {
    XcdBarrier b; b.bar = bar; b.x = xb_xcc_id(); b.st = st;
    if (threadIdx.x == 0) (void)xb_add(&bar[XB_XCNT(b.x)], 1u);
    return b;
}
__device__ __forceinline__ void xcd_barrier_complete(unsigned* bar, unsigned x, unsigned& nloc, unsigned& nx) {
    const unsigned G = gridDim.x * gridDim.y * gridDim.z;
    unsigned sum, cnt, mine, sp = 0u;
    for (;;) {
        sum = 0u; cnt = 0u; mine = 0u;
#pragma unroll
        for (unsigned j = 0; j < 16; ++j) { const unsigned c = xb_ld(&bar[XB_XCNT(j)]); sum += c; cnt += (c > 0u) ? 1u : 0u; mine = (j == x) ? c : mine; }
        if (sum == G) break;
        __builtin_amdgcn_s_sleep(1);
        if ((++sp & 255u) == 0u) { if (xb_ld(&bar[XB_TMO])) break; if (sp > XB_SPIN_CAP) { atomicAdd(&bar[XB_TMO], 1u); break; } }
    }
    nloc = mine > 0u ? mine : 1u; nx = cnt > 0u ? cnt : 1u;
}
__device__ __forceinline__ void xcd_barrier(const XcdBarrier& b) {
    asm volatile("s_waitcnt vmcnt(0)" ::: "memory");
    __syncthreads();
    if (threadIdx.x == 0) {
        unsigned* bar = b.bar;
        __builtin_amdgcn_s_waitcnt(0);
        unsigned nloc = b.st[0], nx = b.st[1];
        if (nloc == 0u) { xcd_barrier_complete(bar, b.x, nloc, nx); b.st[0] = nloc; b.st[1] = nx; }
        const unsigned old = xb_add(&bar[XB_XSUB(b.x)], 1u);
        const unsigned gen = old / nloc;
        if (old + 1u == (gen + 1u) * nloc) {
            __builtin_amdgcn_fence(__ATOMIC_RELEASE, "agent");
            asm volatile("s_waitcnt vmcnt(0)" ::: "memory");
            const unsigned og = xb_add(&bar[XB_TOP], 1u);
            const unsigned tg = og / nx;
            if (og + 1u == (tg + 1u) * nx) xb_add(&bar[XB_TOPGEN], 1u);
            else XB_SPIN(xb_ld(&bar[XB_TOPGEN]) == tg, bar);
            __builtin_amdgcn_fence(__ATOMIC_ACQUIRE, "agent");
            xb_add(&bar[XB_XGEN(b.x)], 1u);
            asm volatile("s_waitcnt vmcnt(0)" ::: "memory");
        } else {
            XB_SPIN(xb_ld(&bar[XB_XGEN(b.x)]) == gen, bar);
            __builtin_amdgcn_fence(__ATOMIC_ACQUIRE, "agent");
            asm volatile("s_waitcnt vmcnt(0)" ::: "memory");
        }
    }
    __syncthreads();
}

struct Params {
    const float* x; const float* c; const float* ctx; const float* c_ctx; const float* mod_w; const float* mod_b; const float* pre_norm; const float* post_norm;
    const float* w_in; const float* mla_q_norm; const float* mla_w_uq; const float* mla_kv_norm; const float* mla_w_ukv; const float* pool_w; const float* pool_scale;
    const float* af_w2; const float* af_b; const float* ab_w2; const float* ab_b; const float* gla_norm; const float* w_bm; const float* w_bp; const float* w_bg; const float* w_out;
    float* out; unsigned char* ws; int ph_lo, ph_hi;
};

constexpr int BK = 64, HALF = 128, HTB = HALF * BK * 2;
__device__ __forceinline__ int lds_byte(int r, int c) { const int st = (r >> 4) * 2 + (c >> 5), rr = r & 15, cc = c & 31, ob = rr * 64 + cc * 2; return st * 1024 + (ob ^ (((ob >> 9) & 1) << 5)); }
__device__ __forceinline__ void stage_rc(int b, int& R, int& C) { const int st = b / 1024, sb = b % 1024, swz = sb ^ (((sb >> 9) & 1) << 5); R = (st >> 1) * 16 + swz / 64; C = (st & 1) * 32 + (swz % 64) / 2; }
__device__ __forceinline__ int perm32(int rho) { const int n = rho >> 4, i = rho & 15; return 8 * (i >> 2) + 4 * n + (i & 3); }

enum { EP_ZIN = 0, EP_Q = 1, EP_KV = 2, EP_GATE = 3, EP_MERGE = 4, EP_OUT = 5 };
struct GUnit { const char* A; const char* B; int lda2; int nt; int kind; int pm; int pn; int aux; };

__device__ __forceinline__ bool tile_of(long L, int nM, int nN, int& pm, int& pn) {
    const int nwg = nM * nN; if (L >= nwg) return false;
    int wgid = (int)L; { const int q = nwg / 8, r = nwg % 8, xcd = wgid % 8, off = wgid / 8; wgid = (xcd < r ? xcd * (q + 1) : r * (q + 1) + (xcd - r) * q) + off; }
    const int nig = 8 * nN, gid = wgid / nig, fm = gid * 8, gsz = (nM - fm) < 8 ? (nM - fm) : 8;
    pm = fm + ((wgid % nig) % gsz); pn = (wgid % nig) / gsz; return true;
}

struct GSched {
    int mode;
    int G, c; int latent_only;
    const char* Z; const char* H; const char* W;
    __device__ __forceinline__ int rowtile(int lt) const { return latent_only ? ((lt >> 3) * 9 + 1 + (lt & 7)) : lt; }
    __device__ __forceinline__ int nrt() const { return latent_only ? 256 : 288; }
    __device__ __forceinline__ bool next(int i, GUnit& u) const {
        int pm, pn;
        if (mode == 0) {
            if (latent_only) {
                const long L = (long)i * G + c;
                if (L < 256 * 14) { tile_of(L, 256, 14, pm, pn); pm = rowtile(pm); }
                else { const int L2 = (int)(L - 256 * 14); if (L2 >= 128) return false; pm = (L2 >> 2) * 9; const int q = L2 & 3; pn = (q == 0) ? 1 : (4 + q); }
            } else
            if (!tile_of((long)i * G + c, 288, 14, pm, pn)) return false;
            u.A = H + (size_t)pm * 256 * 2048; u.lda2 = 2048; u.B = W + W_IN + (size_t)pn * 256 * 2048; u.nt = 16; u.kind = EP_ZIN; u.pm = pm; u.pn = pn; u.aux = 0; return true;
        } else if (mode == 1) {
            const long L = (long)i * G + c; const int nq = nrt() * 4;
            if (L < nq) { tile_of(L, nrt(), 4, pm, pn); pm = rowtile(pm);
                u.A = Z + (size_t)pm * 256 * (ZP * 2) + ZQ * 2; u.lda2 = ZP * 2; u.B = W + W_UQ + (size_t)pn * 256 * 512; u.nt = 4; u.kind = EP_Q; u.pm = pm; u.pn = pn; u.aux = 0; return true; }
            if (!tile_of(L - nq, 288, 4, pm, pn)) return false;
            u.A = Z + (size_t)pm * 256 * (ZP * 2) + ZKV * 2; u.lda2 = ZP * 2; u.B = W + W_UKV + (size_t)pn * 256 * 512; u.nt = 4; u.kind = EP_KV; u.pm = pm; u.pn = pn; u.aux = 0; return true;
        } else if (mode == 2) {
            const int grp = i >> 2, sub = i & 3;
            if (!tile_of((long)grp * G + c, nrt(), 4, pm, pn)) return false;
            pm = rowtile(pm); u.pm = pm; u.pn = pn; u.aux = sub;
            if (sub < 3) { u.A = H + (size_t)pm * 256 * 2048; u.lda2 = 2048; u.B = W + W_M + (size_t)(sub * 1024 + pn * 256) * 2048; u.nt = 16; u.kind = EP_GATE; }
            else { u.A = Z + (size_t)pm * 256 * (ZP * 2) + ZYM * 2; u.lda2 = ZP * 2; u.B = W + W_BR + (size_t)pn * 256 * 3072; u.nt = 24; u.kind = EP_MERGE; }
            return true;
        } else {
            if (!tile_of((long)i * G + c, nrt(), 4, pm, pn)) return false;
            pm = rowtile(pm);
            u.A = Z + (size_t)pm * 256 * (ZP * 2); u.lda2 = ZP * 2; u.B = W + W_OUT + (size_t)pn * 256 * 2048; u.nt = 16; u.kind = EP_OUT; u.pm = pm; u.pn = pn; u.aux = 0; return true;
        }
    }
};

struct GEpi {
    bf16_t* Z; bf16_t* KR; float* ssq_q; float* ssq_kv; bf16_t* Qb; bf16_t* KVb; unsigned char* gscr; const f32x2* tab;
    __device__ __forceinline__ void mid(f32x4 (&acc)[2][2][4][2], int which, int tid) const {
        unsigned t16 = (unsigned)tid * 16u; asm volatile("" : "+v"(t16));
#pragma unroll
        for (int ab = 0; ab < 4; ++ab) {
            u32x4 ga[4], gb[4];
#pragma unroll
            for (int m = 0; m < 4; ++m) { const unsigned char* sb = gscr + (size_t)((which * 16 + ab * 4 + m) * 8192);
                ga[m] = *(const u32x4*)(sb + t16); gb[m] = *(const u32x4*)(sb + 16 * 8192 + t16); }
            __builtin_amdgcn_sched_barrier(0);
#pragma unroll
            for (int m = 0; m < 4; ++m) { f32x4& a0 = acc[ab >> 1][ab & 1][m][0]; f32x4& a1 = acc[ab >> 1][ab & 1][m][1];
                a0[0] *= (1.f + bflo(gb[m].x)) * frcp(1.f + bflo(ga[m].x)); a0[1] *= (1.f + bfhi(gb[m].x)) * frcp(1.f + bfhi(ga[m].x));
                a0[2] *= (1.f + bflo(gb[m].y)) * frcp(1.f + bflo(ga[m].y)); a0[3] *= (1.f + bfhi(gb[m].y)) * frcp(1.f + bfhi(ga[m].y));
                a1[0] *= (1.f + bflo(gb[m].z)) * frcp(1.f + bflo(ga[m].z)); a1[1] *= (1.f + bfhi(gb[m].z)) * frcp(1.f + bfhi(ga[m].z));
                a1[2] *= (1.f + bflo(gb[m].w)) * frcp(1.f + bflo(ga[m].w)); a1[3] *= (1.f + bfhi(gb[m].w)) * frcp(1.f + bfhi(ga[m].w)); }
            __builtin_amdgcn_sched_barrier(0);
        }
    }
    __device__ __forceinline__ void operator()(f32x4 (&acc)[2][2][4][2], const GUnit& u, int wr, int wc, int fr, int fq, int tid) const {
        const int k = u.kind;
        if (k == EP_ZIN) { if (u.pn <= 1) run<EP_ZIN>(acc, u, wr, wc, fr, fq, tid); else if (u.pn >= 8) zin_simple<2>(acc, u, wr, wc, fr, fq); else if (u.pn == 4) zin_simple<1>(acc, u, wr, wc, fr, fq); else zin_simple<0>(acc, u, wr, wc, fr, fq); }
        else if (k == EP_Q) run<EP_Q>(acc, u, wr, wc, fr, fq, tid); else if (k == EP_KV) run<EP_KV>(acc, u, wr, wc, fr, fq, tid);
        else if (k == EP_GATE) run<EP_GATE>(acc, u, wr, wc, fr, fq, tid); else if (k == EP_MERGE) run<EP_MERGE>(acc, u, wr, wc, fr, fq, tid); else run<EP_OUT>(acc, u, wr, wc, fr, fq, tid);
    }
    template <int ACT> __device__ __forceinline__ void zin_simple(f32x4 (&acc)[2][2][4][2], const GUnit& u, int wr, int wc, int fr, int fq) const {
#pragma unroll
        for (int ai = 0; ai < 2; ++ai)
#pragma unroll
            for (int m = 0; m < 4; ++m) {
                bf16_t* rowp = Z + (size_t)(u.pm * 256 + ai * 128 + wr * 64 + m * 16 + fr) * ZP + u.pn * 256 + wc * 32 + 8 * fq;
#pragma unroll
                for (int bj = 0; bj < 2; ++bj) { f32x4 v0 = acc[ai][bj][m][0], v1 = acc[ai][bj][m][1];
                    if (ACT == 1) { v0 *= 0.125f; v1 *= 0.125f; }
                    if (ACT == 2) {
#pragma unroll
                        for (int j = 0; j < 4; ++j) { v0[j] = siluf_(v0[j]); v1[j] = siluf_(v1[j]); } }
                    *(u32x4*)(rowp + bj * 128) = pack8(v0, v1); }
                __builtin_amdgcn_sched_barrier(0);
            }
    }
    template <int KIND> __device__ __forceinline__ void run(f32x4 (&acc)[2][2][4][2], const GUnit& u, int wr, int wc, int fr, int fq, int tid) const {
        constexpr int kind = KIND; const int pn = u.pn;
        unsigned t16 = (unsigned)tid * 16u; asm volatile("" : "+v"(t16));
        u32x4 ggv[16];
        if (kind == EP_MERGE) {
#pragma unroll
            for (int i = 0; i < 16; ++i) ggv[i] = *(const u32x4*)(gscr + (size_t)((2 * 16 + i) * 8192) + t16);
        } else {
#pragma unroll
            for (int i = 0; i < 16; ++i) ggv[i] = (u32x4){0u, 0u, 0u, 0u}; }
        __builtin_amdgcn_sched_barrier(0);
#pragma unroll
        for (int ai = 0; ai < 2; ++ai)
#pragma unroll
            for (int m = 0; m < 4; ++m) {
                const int row = u.pm * 256 + ai * 128 + wr * 64 + m * 16 + fr;
                if (kind == EP_ZIN) {
                    const int act = (pn == 4) ? 1 : (pn >= 8 ? 2 : 0);
                    float ss0 = 0.f, ss1 = 0.f;
#pragma unroll
                    for (int bj = 0; bj < 2; ++bj) {
                        f32x4 v0 = acc[ai][bj][m][0], v1 = acc[ai][bj][m][1];
                        if (act == 1) { v0 *= 0.125f; v1 *= 0.125f; }
                        if (act == 2) {
#pragma unroll
                            for (int j = 0; j < 4; ++j) { v0[j] = siluf_(v0[j]); v1[j] = siluf_(v1[j]); } }
                        *(u32x4*)(Z + (size_t)row * ZP + pn * 256 + bj * 128 + wc * 32 + 8 * fq) = pack8(v0, v1);
                        if (pn <= 1) { float s = 0.f;
#pragma unroll
                            for (int j = 0; j < 4; ++j) s += v0[j] * v0[j] + v1[j] * v1[j];
                            if (bj == 0) ss0 = s; else ss1 = s; }
                    }
                    if (pn <= 1) {
                        float s = (pn == 0) ? (ss0 + ss1) : ss0;
                        s += __shfl_xor(s, 16); s += __shfl_xor(s, 32);
                        if (fq == 0) atomicAdd((pn == 0 ? ssq_q : ssq_kv) + row, s);
                        if (pn == 1 && wc < 2) {
                            const f32x4 mn = acc[ai][1][m][0], rt = acc[ai][1][m][1]; f32x4 o = mn;
                            const int tok = row % TOK;
                            if (tok >= CTXL) { const int t = tok - CTXL; const int pos = (wc == 0) ? (t >> 6) : (t & 63);
#pragma unroll
                                for (int j = 0; j < 4; ++j) { const float rv = (float)pos * (fexp2(-(float)(4 * (fq & 1) + j) * (13.287712379549449f / 8.f)) * 0.15915494309189535f);     const float fr_ = rv - floorf(rv); o[j] = mn[j] * __builtin_amdgcn_cosf(fr_) + rt[j] * __builtin_amdgcn_sinf(fr_); } }
                            u32x2 pk; pk.x = cvtpk(o[0], o[1]); pk.y = cvtpk(o[2], o[3]);
                            *(u32x2*)(KR + (size_t)row * 32 + 4 * (4 * wc + fq)) = pk;
                        }
                    }
                } else if (kind == EP_Q) {
                    const float rs = __builtin_amdgcn_rsqf(ssq_q[row] * (1.f / 256.f) + EPS) * QSCALE;
                    const int tok = row % TOK;
#pragma unroll
                    for (int bj = 0; bj < 2; ++bj) {
                        const int head = 2 * pn + bj;
                        f32x4 v0 = acc[ai][bj][m][0] * rs, v1 = acc[ai][bj][m][1] * rs;
                        if (wc < 2) { *(u32x4*)(Qb + (size_t)row * 768 + head * 96 + wc * 32 + 8 * fq) = pack8(v0, v1); }
                        else { f32x4 o = v0; const int g = 4 * (wc - 2) + fq;
                            if (tok >= CTXL) { const int t = tok - CTXL; const int pos = (wc == 2) ? (t >> 6) : (t & 63);
#pragma unroll
                                for (int j = 0; j < 4; ++j) { const float rv = (float)pos * (fexp2(-(float)(4 * (fq & 1) + j) * (13.287712379549449f / 8.f)) * 0.15915494309189535f);     const float fr_ = rv - floorf(rv); o[j] = v0[j] * __builtin_amdgcn_cosf(fr_) + v1[j] * __builtin_amdgcn_sinf(fr_); } }
                            u32x2 pk; pk.x = cvtpk(o[0], o[1]); pk.y = cvtpk(o[2], o[3]);
                            *(u32x2*)(Qb + (size_t)row * 768 + head * 96 + 64 + 4 * g) = pk; }
                    }
                } else if (kind == EP_KV) {
                    const float rs = __builtin_amdgcn_rsqf(ssq_kv[row] * (1.f / 128.f) + EPS);
#pragma unroll
                    for (int bj = 0; bj < 2; ++bj)
                        *(u32x4*)(KVb + (size_t)row * 1024 + pn * 256 + bj * 128 + wc * 32 + 8 * fq) = pack8(acc[ai][bj][m][0] * rs, acc[ai][bj][m][1] * rs);
                } else if (kind == EP_GATE) {
#pragma unroll
                    for (int bj = 0; bj < 2; ++bj) { f32x4 v0 = acc[ai][bj][m][0], v1 = acc[ai][bj][m][1];
#pragma unroll
                        for (int j = 0; j < 4; ++j) { v0[j] = fminf(fexp(-v0[j]), 1e18f); v1[j] = fminf(fexp(-v1[j]), 1e18f); }
                        *(u32x4*)(gscr + (size_t)((u.aux * 16 + (ai * 2 + bj) * 4 + m) * 8192) + t16) = pack8(v0, v1); }
                } else if (kind == EP_MERGE) {
#pragma unroll
                    for (int bj = 0; bj < 2; ++bj) {
                        const u32x4 gg = ggv[(ai * 2 + bj) * 4 + m];
                        f32x4 v0 = acc[ai][bj][m][0], v1 = acc[ai][bj][m][1];
                        v0[0] *= frcp(1.f + bflo(gg.x)); v0[1] *= frcp(1.f + bfhi(gg.x)); v0[2] *= frcp(1.f + bflo(gg.y)); v0[3] *= frcp(1.f + bfhi(gg.y));
                        v1[0] *= frcp(1.f + bflo(gg.z)); v1[1] *= frcp(1.f + bfhi(gg.z)); v1[2] *= frcp(1.f + bflo(gg.w)); v1[3] *= frcp(1.f + bfhi(gg.w));
                        *(u32x4*)(Z + (size_t)row * ZP + pn * 256 + bj * 128 + wc * 32 + 8 * fq) = pack8(v0, v1); }
                } else {
#pragma unroll
                    for (int bj = 0; bj < 2; ++bj)
                        *(u32x4*)(Z + (size_t)row * ZP + 1024 + pn * 256 + bj * 128 + wc * 32 + 8 * fq) = pack8(acc[ai][bj][m][0], acc[ai][bj][m][1]);
                }
                __builtin_amdgcn_sched_barrier(0);
            }
    }
};

__device__ __forceinline__ void gemm_phase(LAS unsigned char* lds, const GSched& S, const GEpi& E, bool dry) {
    int tid = threadIdx.x; asm volatile("" : "+v"(tid)); const int wid = __builtin_amdgcn_readfirstlane(tid >> 6), lane = tid & 63, wr = wid >> 2, wc = wid & 3, fr = lane & 15, fq = lane >> 4;
    int R0, C0; stage_rc(tid * 16, R0, C0);
    const int Rb0 = (R0 & ~31) + perm32(R0 & 31); const int C02 = C0 * 2;
    const unsigned ldsw = (unsigned)wid * 1024u;
    const int aoff = lds_byte(wr * 64 + fr, fq * 8), boff = lds_byte(wc * 32 + fr, fq * 8);
#define PG8_SA(b, h) (((b) * 2 + (h)) * HTB)
#define PG8_SB(b, h) ((4 + (b) * 2 + (h)) * HTB)
#define PG8_STAGE(bufoff, gbase, ld, rowv) do { const unsigned _v = (unsigned)((rowv) * (ld) + C02); \
        __builtin_amdgcn_global_load_lds((const unsigned*)((const char*)(gbase) + _v), (LAS unsigned*)(lds + (bufoff) + ldsw), 16, 0, 0); \
        __builtin_amdgcn_global_load_lds((const unsigned*)((const char*)(gbase) + (size_t)64 * (ld) + _v), (LAS unsigned*)(lds + (bufoff) + ldsw + 8192), 16, 0, 0); } while (0)
#define PG8_LDA(dst, b, h) do { _Pragma("unroll") for (int m = 0; m < 4; ++m) _Pragma("unroll") for (int k = 0; k < 2; ++k) dst[m][k] = *(const LAS bf16x8*)(lds + PG8_SA(b, h) + aoff + m * 2048 + k * 1024); } while (0)
#define PG8_LDB(dst, b, h) do { _Pragma("unroll") for (int n = 0; n < 2; ++n) _Pragma("unroll") for (int k = 0; k < 2; ++k) dst[n][k] = *(const LAS bf16x8*)(lds + PG8_SB(b, h) + boff + n * 2048 + k * 1024); } while (0)
#define PG8_MMA(ai, bj, At, Bt) do { __builtin_amdgcn_s_setprio(1); _Pragma("unroll") for (int m = 0; m < 4; ++m) _Pragma("unroll") for (int n = 0; n < 2; ++n) _Pragma("unroll") for (int k = 0; k < 2; ++k) \
        acc[ai][bj][m][n] = __builtin_amdgcn_mfma_f32_16x16x32_bf16(Bt[n][k], At[m][k], acc[ai][bj][m][n], 0, 0, 0); __builtin_amdgcn_s_setprio(0); } while (0)
#define PG8_WAIT_V(n) asm volatile("s_waitcnt vmcnt(" #n ")" ::: "memory")
#define PG8_WAIT_L(n) asm volatile("s_waitcnt lgkmcnt(" #n ")" ::: "memory")
#define PG8_BAR __builtin_amdgcn_s_barrier()
#define PG8_SCHED __builtin_amdgcn_sched_barrier(0)
    GUnit cur, nxt; int ui = 0;
    if (!S.next(0, cur)) return;
    f32x4 acc[2][2][4][2];
#pragma unroll
    for (int a = 0; a < 2; ++a)
#pragma unroll
        for (int b = 0; b < 2; ++b)
#pragma unroll
            for (int m = 0; m < 4; ++m)
#pragma unroll
                for (int n = 0; n < 2; ++n) acc[a][b][m][n] = (f32x4){0.f, 0.f, 0.f, 0.f};
    bf16x8 At[4][2], B0[2][2], B1[2][2];
    const char* cA = cur.A; const char* cB = cur.B;
    int ldA = cur.lda2, ldB = cur.nt * 128;
    const size_t kstep = 128;
    PG8_STAGE(PG8_SB(0, 0), cB, ldB, Rb0); PG8_STAGE(PG8_SB(0, 1), cB + (size_t)HALF * ldB, ldB, Rb0); PG8_STAGE(PG8_SA(0, 0), cA, ldA, R0); PG8_STAGE(PG8_SA(0, 1), cA + (size_t)HALF * ldA, ldA, R0);
    if (wr == 1) PG8_BAR;
    PG8_WAIT_V(2); PG8_BAR;
    PG8_STAGE(PG8_SB(1, 0), cB + kstep, ldB, Rb0); PG8_STAGE(PG8_SA(1, 0), cA + kstep, ldA, R0); PG8_STAGE(PG8_SB(1, 1), cB + (size_t)HALF * ldB + kstep, ldB, Rb0);
    PG8_WAIT_V(6); PG8_BAR;
    for (;;) {
        const bool has_next = S.next(ui + 1, nxt);
        const char* nA = has_next ? nxt.A : cA; const char* nB = has_next ? nxt.B : cB;
        const int nldA = has_next ? nxt.lda2 : ldA, nldB = has_next ? nxt.nt * 128 : ldB;
        const int nt = cur.nt;
        for (int t = 0; t < nt; t += 2) {
            const bool last = (t == nt - 2);
            if (cur.kind == EP_MERGE && (t == 8 || t == 16)) E.mid(acc, t == 8 ? 0 : 1, tid);
            const char* a1 = cA + (size_t)(t + 1) * kstep;
            const char* a2 = last ? nA : cA + (size_t)(t + 2) * kstep; const char* b2 = last ? nB : cB + (size_t)(t + 2) * kstep;
            const char* a3 = a2 + kstep; const char* b3 = b2 + kstep;
            const int xldA = last ? nldA : ldA, xldB = last ? nldB : ldB;
            PG8_LDB(B0, 0, 0); PG8_LDB(B1, 0, 1); PG8_SCHED; PG8_LDA(At, 0, 0); PG8_STAGE(PG8_SA(1, 1), a1 + (size_t)HALF * ldA, ldA, R0);
            PG8_WAIT_V(8); PG8_WAIT_L(0); PG8_BAR; PG8_MMA(0, 0, At, B0); PG8_MMA(0, 1, At, B1); PG8_BAR; PG8_SCHED;
            PG8_LDA(At, 0, 1); PG8_STAGE(PG8_SB(0, 0), b2, xldB, Rb0); PG8_STAGE(PG8_SB(0, 1), b2 + (size_t)HALF * xldB, xldB, Rb0); PG8_STAGE(PG8_SA(0, 0), a2, xldA, R0);
            PG8_WAIT_V(8); PG8_WAIT_L(0); PG8_BAR; PG8_MMA(1, 0, At, B0); PG8_MMA(1, 1, At, B1); PG8_BAR; PG8_SCHED;
            PG8_LDB(B0, 1, 0); PG8_LDB(B1, 1, 1); PG8_SCHED; PG8_LDA(At, 1, 0); PG8_STAGE(PG8_SA(0, 1), a2 + (size_t)HALF * xldA, xldA, R0);
            PG8_WAIT_V(8); PG8_WAIT_L(0); PG8_BAR; PG8_MMA(0, 0, At, B0); PG8_MMA(0, 1, At, B1); PG8_BAR; PG8_SCHED;
            PG8_LDA(At, 1, 1); PG8_STAGE(PG8_SB(1, 0), b3, xldB, Rb0); PG8_STAGE(PG8_SB(1, 1), b3 + (size_t)HALF * xldB, xldB, Rb0); PG8_STAGE(PG8_SA(1, 0), a3, xldA, R0);
            PG8_WAIT_V(8); PG8_WAIT_L(0); PG8_BAR; PG8_MMA(1, 0, At, B0); PG8_MMA(1, 1, At, B1); PG8_BAR; PG8_SCHED;
        }
        if (wr == 0) PG8_BAR;
        if (!dry) E(acc, cur, wr, wc, fr, fq, tid);
        if (!has_next) break;
#pragma unroll
        for (int a = 0; a < 2; ++a)
#pragma unroll
            for (int b = 0; b < 2; ++b)
#pragma unroll
                for (int m = 0; m < 4; ++m)
#pragma unroll
                    for (int n = 0; n < 2; ++n) acc[a][b][m][n] = (f32x4){0.f, 0.f, 0.f, 0.f};
        cur = nxt; cA = nA; cB = nB; ldA = nldA; ldB = nldB; ++ui;
        if (wr == 1) PG8_BAR;
    }
    PG8_WAIT_V(0);
    PG8_BAR;
}

constexpr int AK_PITCH = 208, AK_BYTES = 64 * AK_PITCH, AV_BYTES = 8192;
constexpr int A_K0 = 0, A_V0 = 4 * AK_BYTES, A_WS = A_V0 + 4 * AV_BYTES, A_OST = A_WS + 2048, A_OP = 144, A_END = A_OST + 8 * 32 * A_OP;
static_assert(A_END <= 147200, "attention lds");
__device__ __forceinline__ float max3f(float a, float b, float c) { return fmaxf(fmaxf(a, b), c); }
__device__ __forceinline__ void attn_unit(LAS char* lds, const bf16_t* Qp, const bf16_t* KVp, const bf16_t* KRp, int ntiles, bf16_t* Yp, bool dry) {
    int tid = threadIdx.x; asm volatile("" : "+v"(tid)); const int lane = tid & 63, r32 = lane & 31, hi = lane >> 5; const int wid = __builtin_amdgcn_readfirstlane(tid >> 6);
    LAS float* wsf = (LAS float*)(lds + A_WS) + wid * 64;
    const int krow = tid >> 3, kc = tid & 7, rrow = tid >> 2, rc = tid & 3;
    const bf16_t* gk = KVp + (size_t)krow * 1024 + kc * 8;
    const bf16_t* gv = gk + 512;
    const bf16_t* gr = KRp + (size_t)rrow * 32 + rc * 8;
    const int lk = krow * AK_PITCH + kc * 16, lr = rrow * AK_PITCH + 128 + rc * 16, lv = (kc >> 2) * 4096 + krow * 64 + (kc & 3) * 16;
    const bool rth = tid < 256;
    u32x4 skA, svA, srA = {0u, 0u, 0u, 0u}, skB, svB, srB = {0u, 0u, 0u, 0u};
#define AT_LOAD(X, t) do { const size_t adv_ = (size_t)(t) * 64; sk##X = *(const u32x4*)(gk + adv_ * 1024); sv##X = *(const u32x4*)(gv + adv_ * 1024); if (rth) sr##X = *(const u32x4*)(gr + adv_ * 32); } while (0)
#define AT_STORE(X, slot) do { *(LAS u32x4*)(lds + A_K0 + (slot) * AK_BYTES + lk) = sk##X; *(LAS u32x4*)(lds + A_V0 + (slot) * AV_BYTES + lv) = sv##X; if (rth) *(LAS u32x4*)(lds + A_K0 + (slot) * AK_BYTES + lr) = sr##X; } while (0)
    AT_LOAD(A, 0); AT_LOAD(B, 1);
    bf16x8 qf[6];
    { const bf16_t* qrow = Qp + (size_t)(wid * 32 + r32) * 768;
#pragma unroll
      for (int s = 0; s < 6; ++s) qf[s] = *(const bf16x8*)(qrow + 16 * s + 8 * hi); }
    AT_STORE(A, 0); AT_STORE(B, 1);
    __syncthreads();
    float mref = 0.f, lsum = 0.f;
    f32x16 o0 = {}, o1 = {};
    const int g16 = (lane >> 4) & 1, q4 = (lane & 15) >> 2, p4 = lane & 3;
    const int vtr = (4 * hi + q4) * 64 + (16 * g16 + 4 * p4) * 2;
#define AT_QK(slot, P0, P1) do { const LAS char* Kb = lds + A_K0 + (slot) * AK_BYTES; \
        _Pragma("unroll") for (int s = 0; s < 6; ++s) { \
            const bf16x8 k0 = *(const LAS bf16x8*)(Kb + r32 * AK_PITCH + (16 * s + 8 * hi) * 2); \
            const bf16x8 k1 = *(const LAS bf16x8*)(Kb + (r32 + 32) * AK_PITCH + (16 * s + 8 * hi) * 2); \
            P0 = __builtin_amdgcn_mfma_f32_32x32x16_bf16(k0, qf[s], P0, 0, 0, 0); P1 = __builtin_amdgcn_mfma_f32_32x32x16_bf16(k1, qf[s], P1, 0, 0, 0); } } while (0)
#define AT_SMPV(slot, first, p0, p1) do { const LAS char* Vb = lds + A_V0 + (slot) * AV_BYTES; \
        float ra = max3f(p0[0], p0[1], p1[0]), rb = max3f(p0[2], p0[3], p1[1]); ra = max3f(ra, p1[2], p1[3]); \
        _Pragma("unroll") for (int r = 4; r < 16; r += 4) { ra = max3f(ra, p0[r], p0[r + 1]); rb = max3f(rb, p0[r + 2], p0[r + 3]); ra = max3f(ra, p1[r], p1[r + 1]); rb = max3f(rb, p1[r + 2], p1[r + 3]); } \
        float rm = fmaxf(ra, rb); rm = fmaxf(rm, __shfl_xor(rm, 32)) - mref; \
        if ((first) || __any(rm > 8.f)) { \
            const float dl = (first) ? rm : fmaxf(rm, 0.f); mref += dl; const float al = fexp2(-dl); lsum *= al; \
            if (!(first)) { if (hi == 0) wsf[r32] = al; \
                asm volatile("s_waitcnt lgkmcnt(0)" ::: "memory"); \
                _Pragma("unroll") for (int k = 0; k < 4; ++k) { const f32x4 a = *(const LAS f32x4*)(wsf + 8 * k + 4 * hi); \
                    _Pragma("unroll") for (int j = 0; j < 4; ++j) { o0[4 * k + j] *= a[j]; o1[4 * k + j] *= a[j]; } } } \
        } \
        _Pragma("unroll") for (int r = 0; r < 16; ++r) { p0[r] = fexp2(p0[r] - mref); p1[r] = fexp2(p1[r] - mref); } \
        { float sa = p0[0] + p1[0], sb = p0[1] + p1[1], sc_ = p0[2] + p1[2], sd = p0[3] + p1[3]; \
          _Pragma("unroll") for (int r = 4; r < 16; r += 4) { sa += p0[r] + p1[r]; sb += p0[r + 1] + p1[r + 1]; sc_ += p0[r + 2] + p1[r + 2]; sd += p0[r + 3] + p1[r + 3]; } \
          lsum += (sa + sb) + (sc_ + sd); } \
        u32x4 pw[4]; \
        pw[0] = (u32x4){cvtpk(p0[0], p0[1]), cvtpk(p0[2], p0[3]), cvtpk(p0[4], p0[5]), cvtpk(p0[6], p0[7])}; \
        pw[1] = (u32x4){cvtpk(p0[8], p0[9]), cvtpk(p0[10], p0[11]), cvtpk(p0[12], p0[13]), cvtpk(p0[14], p0[15])}; \
        pw[2] = (u32x4){cvtpk(p1[0], p1[1]), cvtpk(p1[2], p1[3]), cvtpk(p1[4], p1[5]), cvtpk(p1[6], p1[7])}; \
        pw[3] = (u32x4){cvtpk(p1[8], p1[9]), cvtpk(p1[10], p1[11]), cvtpk(p1[12], p1[13]), cvtpk(p1[14], p1[15])}; \
        _Pragma("unroll") for (int u = 0; u < 4; ++u) { \
            const LAS char* vb = Vb + vtr + u * 16 * 64; \
            const s16x4 a0 = trread(vb), a1 = trread(vb + 8 * 64), b0 = trread(vb + 4096), b1 = trread(vb + 4096 + 8 * 64); \
            o0 = __builtin_amdgcn_mfma_f32_32x32x16_bf16(__builtin_bit_cast(bf16x8, pw[u]), MK8(a0, a1), o0, 0, 0, 0); \
            o1 = __builtin_amdgcn_mfma_f32_32x32x16_bf16(__builtin_bit_cast(bf16x8, pw[u]), MK8(b0, b1), o1, 0, 0, 0); } \
    } while (0)
    for (int t = 0; t < ntiles; t += 2) {
        const int sb0 = (t & 2);
        const bool more = (t + 2 < ntiles);
        f32x16 pa0 = {}, pa1 = {}, pb0 = {}, pb1 = {};
        AT_QK(sb0, pa0, pa1);
        AT_QK(sb0 + 1, pb0, pb1);
        if (t == 0) AT_SMPV(sb0, true, pa0, pa1); else AT_SMPV(sb0, false, pa0, pa1);
        __builtin_amdgcn_sched_barrier(0);
        if (more) { AT_LOAD(A, t + 2); AT_LOAD(B, t + 3); }
        AT_SMPV(sb0 + 1, false, pb0, pb1);
        if (more) { AT_STORE(A, sb0 ^ 2); AT_STORE(B, (sb0 ^ 2) + 1); }
        __syncthreads();
    }
#undef AT_LOAD
#undef AT_STORE
#undef AT_QK
#undef AT_SMPV
    lsum += __shfl_xor(lsum, 32);
    if (hi == 0) wsf[r32] = frcp(lsum);
    asm volatile("s_waitcnt lgkmcnt(0)" ::: "memory");
    LAS char* ost = lds + A_OST + wid * (32 * A_OP);
#pragma unroll
    for (int k = 0; k < 4; ++k) { const f32x4 a = *(const LAS f32x4*)(wsf + 8 * k + 4 * hi);
#pragma unroll
        for (int j = 0; j < 4; ++j) { const int r = 4 * k + j; LAS bf16_t* op = (LAS bf16_t*)(ost + crow(r, hi) * A_OP) + r32;
            op[0] = f2bf(o0[r] * a[j]); op[32] = f2bf(o1[r] * a[j]); } }
    asm volatile("s_waitcnt lgkmcnt(0)" ::: "memory");
#pragma unroll
    for (int i = 0; i < 4; ++i) { const int id = lane + 64 * i, row = id >> 3, ch = id & 7;
        const u32x4 ov = *(const LAS u32x4*)(ost + row * A_OP + ch * 16);
        bf16_t* yp = Yp + (size_t)(wid * 32 + row) * ZP + ch * 8;
        if (!dry) { const u32x4 gv = *(const u32x4*)yp; u32x4 w;
            w.x = cvtpk(bflo(ov.x) * bflo(gv.x), bfhi(ov.x) * bfhi(gv.x)); w.y = cvtpk(bflo(ov.y) * bflo(gv.y), bfhi(ov.y) * bfhi(gv.y));
            w.z = cvtpk(bflo(ov.z) * bflo(gv.z), bfhi(ov.z) * bfhi(gv.z)); w.w = cvtpk(bflo(ov.w) * bflo(gv.w), bfhi(ov.w) * bfhi(gv.w));
            *(u32x4*)yp = w; } }
    __syncthreads();
}

constexpr int GP = 144, GARR = 64 * GP;
constexpr int G_Q = 0, G_K = GARR, G_KD = 2 * GARR, G_V = 3 * GARR, G_AM = 4 * GARR, G_SB = 5 * GARR, G_O = 6 * GARR, G_A16 = 7 * GARR, G_DEC = G_A16 + 2048, G_TOT = G_DEC + 256, G_GROUP = 68096;
static_assert(G_TOT + 512 <= G_GROUP && 2 * G_GROUP <= 147200, "gla lds");
__device__ __forceinline__ void gla_unit(LAS char* lds0, int b, int h, int dvh, bf16_t* Z, bf16_t* OT, const float* afw, const float* afb, const float* abw, const float* abb, bool dry) {
    int tid = threadIdx.x; asm volatile("" : "+v"(tid)); const int lane = tid & 63, r32 = lane & 31, hi = lane >> 5; const int wid = __builtin_amdgcn_readfirstlane(tid >> 6);
    const int dir = wid >> 2, wg = wid & 3, tg = tid & 255;
    LAS char* lds = lds0 + dir * G_GROUP;
    const int g16 = (lane >> 4) & 1, q4 = (lane & 15) >> 2, p4 = lane & 3;
    const int I = wg >> 1, J = wg & 1;
    const float* w2 = dir ? abw : afw; const float* bb = dir ? abb : afb;
    bf16x8 w2b;
    { u32x4 t; t.x = cvtpk(w2[(8 * hi + 0) * 256 + h * 64 + 32 * J + r32], w2[(8 * hi + 1) * 256 + h * 64 + 32 * J + r32]);
      t.y = cvtpk(w2[(8 * hi + 2) * 256 + h * 64 + 32 * J + r32], w2[(8 * hi + 3) * 256 + h * 64 + 32 * J + r32]);
      t.z = cvtpk(w2[(8 * hi + 4) * 256 + h * 64 + 32 * J + r32], w2[(8 * hi + 5) * 256 + h * 64 + 32 * J + r32]);
      t.w = cvtpk(w2[(8 * hi + 6) * 256 + h * 64 + 32 * J + r32], w2[(8 * hi + 7) * 256 + h * 64 + 32 * J + r32]);
      w2b = __builtin_bit_cast(bf16x8, t); }
    const float bias = bb[h * 64 + 32 * J + r32];
    const int zcol_a = dir ? ZAB : ZAF;
    f32x16 S = {};
    for (int i = tg; i < GARR / 4; i += 256) ((LAS unsigned*)(lds + G_SB))[i] = 0u;
    u32x4 pq0, pq1, pk0, pk1, pv0, pv1; u32x2 pa;
    const int lr = tg >> 3, lc = tg & 7, ar = tg >> 2, ac = tg & 3;
#define GLA_CHUNK(s) (dir ? ((s) < 4 ? 3 - (s) : 39 - (s)) : (s))
#define GLA_ROW(rb, i) ((rb) + (dir ? 63 - (i) : (i)))
#define GLA_PREFETCH(s) do { const size_t rb_ = (size_t)b * TOK + 64 * GLA_CHUNK(s); \
        const bf16_t* z0_ = Z + GLA_ROW(rb_, lr) * ZP; const bf16_t* z1_ = Z + GLA_ROW(rb_, lr + 32) * ZP; \
        pq0 = *(const u32x4*)(z0_ + ZGQ + h * 64 + lc * 8); pq1 = *(const u32x4*)(z1_ + ZGQ + h * 64 + lc * 8); \
        pk0 = *(const u32x4*)(z0_ + ZGK + h * 64 + lc * 8); pk1 = *(const u32x4*)(z1_ + ZGK + h * 64 + lc * 8); \
        pv0 = *(const u32x4*)(z0_ + ZGV + h * 128 + dvh * 64 + lc * 8); pv1 = *(const u32x4*)(z1_ + ZGV + h * 128 + dvh * 64 + lc * 8); \
        pa = *(const u32x2*)(Z + GLA_ROW(rb_, ar) * ZP + zcol_a + ac * 4); } while (0)
    GLA_PREFETCH(0);
    for (int s = 0; s < 36; ++s) {
        const int c = GLA_CHUNK(s);
        const size_t rbase = (size_t)b * TOK + 64 * c;
        const int other_step = dir ? c : (c < 4 ? 3 - c : 39 - c);
        const bool second = s > other_step;
        *(LAS u32x4*)(lds + G_Q + lr * GP + lc * 16) = pq0; *(LAS u32x4*)(lds + G_Q + (lr + 32) * GP + lc * 16) = pq1;
        *(LAS u32x4*)(lds + G_K + lr * GP + lc * 16) = pk0; *(LAS u32x4*)(lds + G_K + (lr + 32) * GP + lc * 16) = pk1;
        *(LAS u32x4*)(lds + G_V + lr * GP + lc * 16) = pv0; *(LAS u32x4*)(lds + G_V + (lr + 32) * GP + lc * 16) = pv1;
        *(LAS u32x2*)(lds + G_A16 + ar * 32 + ac * 8) = pa;
        __syncthreads();
        if (s + 1 < 36) GLA_PREFETCH(s + 1);
        u32x4 prv0 = {0u, 0u, 0u, 0u}, prv1 = {0u, 0u, 0u, 0u};
        bf16_t* og0 = OT + GLA_ROW(rbase, lr) * 512 + h * 128 + dvh * 64 + lc * 8;
        bf16_t* og1 = OT + GLA_ROW(rbase, lr + 32) * 512 + h * 128 + dvh * 64 + lc * 8;
        if (second) { prv0 = *(const u32x4*)og0; prv1 = *(const u32x4*)og1; }
        float cs[16];
        {
            f32x16 zc;
#pragma unroll
            for (int r = 0; r < 16; ++r) zc[r] = bias;
            const bf16x8 a = *(const LAS bf16x8*)(lds + G_A16 + (32 * I + r32) * 32 + hi * 16);
            zc = __builtin_amdgcn_mfma_f32_32x32x16_bf16(a, w2b, zc, 0, 0, 0);
#pragma unroll
            for (int r = 0; r < 16; ++r) { const float z = zc[r]; cs[r] = (fminf(z, 0.f) - __logf(1.f + fexp(-fabsf(z)))) * (1.f / 16.f); }
        }
#pragma unroll
        for (int g = 0; g < 4; ++g) { cs[4 * g + 1] += cs[4 * g]; cs[4 * g + 2] += cs[4 * g + 1]; cs[4 * g + 3] += cs[4 * g + 2]; }
        float run = 0.f;
#pragma unroll
        for (int g = 0; g < 4; ++g) {
            const float mine = cs[4 * g + 3]; const float oth = __shfl_xor(mine, 32);
            const float off = run + (hi ? oth : 0.f);
#pragma unroll
            for (int j = 0; j < 4; ++j) cs[4 * g + j] += off;
            run += mine + oth;
        }
        if (hi == 0) ((LAS float*)(lds + G_TOT))[I * 64 + 32 * J + r32] = run;
        asm volatile("s_waitcnt lgkmcnt(0)\n\ts_barrier" ::: "memory");
        const float t0v = ((LAS float*)(lds + G_TOT))[32 * J + r32], t1v = ((LAS float*)(lds + G_TOT))[64 + 32 * J + r32];
        const float pre = I ? t0v : 0.f, tot = t0v + t1v;
        const float etot = fexp(tot);
#pragma unroll
        for (int r = 0; r < 16; ++r) {
            const int ii = 32 * I + crow(r, hi), dd = 32 * J + r32; const float eb = fexp(pre + cs[r]); const float ieb = frcp(eb);
            LAS bf16_t* qp = (LAS bf16_t*)(lds + G_Q) + ii * (GP / 2) + dd; LAS bf16_t* kp = (LAS bf16_t*)(lds + G_K) + ii * (GP / 2) + dd;
            const float qv = bf2f(*qp), kv = bf2f(*kp);
            *qp = f2bf(qv * eb); *kp = f2bf(kv * ieb);
            ((LAS bf16_t*)(lds + G_KD))[ii * (GP / 2) + dd] = f2bf(kv * ieb * etot);
        }
        if (I == 0 && hi == 0) ((LAS float*)(lds + G_DEC))[32 * J + r32] = etot;
        asm volatile("s_waitcnt lgkmcnt(0)\n\ts_barrier" ::: "memory");
        f32x16 oacc = {};
        {
            f32x16 Ac = {};
            if (J <= I) {
#pragma unroll
                for (int k = 0; k < 4; ++k) {
                    const bf16x8 a = *(const LAS bf16x8*)(lds + G_Q + (32 * I + r32) * GP + (16 * k + 8 * hi) * 2);
                    const bf16x8 bq = *(const LAS bf16x8*)(lds + G_K + (32 * J + r32) * GP + (16 * k + 8 * hi) * 2);
                    Ac = __builtin_amdgcn_mfma_f32_32x32x16_bf16(a, bq, Ac, 0, 0, 0);
                }
            }
#pragma unroll
            for (int k = 0; k < 4; ++k) {
                const bf16x8 a = *(const LAS bf16x8*)(lds + G_Q + (32 * I + r32) * GP + (16 * k + 8 * hi) * 2);
                const LAS char* sp = lds + G_SB + (16 * k + 8 * hi + q4) * GP + (32 * J + 16 * g16 + 4 * p4) * 2;
                const s16x4 l0 = trread(sp), l1 = trread(sp + 4 * GP);
                oacc = __builtin_amdgcn_mfma_f32_32x32x16_bf16(a, MK8(l0, l1), oacc, 0, 0, 0);
            }
#pragma unroll
            for (int r = 0; r < 16; ++r) { const int i_ = 32 * I + crow(r, hi), j_ = 32 * J + r32;
                ((LAS bf16_t*)(lds + G_AM))[i_ * (GP / 2) + j_] = f2bf((i_ >= j_) ? Ac[r] : 0.f); }
        }
        asm volatile("s_waitcnt lgkmcnt(0)\n\ts_barrier" ::: "memory");
        {
#pragma unroll
            for (int u = 0; u < 4; ++u) {
                const bf16x8 a = *(const LAS bf16x8*)(lds + G_AM + (32 * I + r32) * GP + (16 * u + 8 * hi) * 2);
                const LAS char* vp = lds + G_V + (16 * u + 8 * hi + q4) * GP + (32 * J + 16 * g16 + 4 * p4) * 2;
                const s16x4 l0 = trread(vp), l1 = trread(vp + 4 * GP);
                oacc = __builtin_amdgcn_mfma_f32_32x32x16_bf16(a, MK8(l0, l1), oacc, 0, 0, 0);
            }
#pragma unroll
            for (int r = 0; r < 16; ++r) ((LAS bf16_t*)(lds + G_O))[(32 * I + crow(r, hi)) * (GP / 2) + 32 * J + r32] = f2bf(oacc[r]);
            const int Dd = I;
#pragma unroll
            for (int k = 0; k < 4; ++k) { const f32x4 dc = *(const LAS f32x4*)(lds + G_DEC + (32 * Dd + 8 * k + 4 * hi) * 4);
#pragma unroll
                for (int j = 0; j < 4; ++j) S[4 * k + j] *= dc[j]; }
#pragma unroll
            for (int u = 0; u < 4; ++u) {
                const LAS char* kp = lds + G_KD + (16 * u + 8 * hi + q4) * GP + (32 * Dd + 16 * g16 + 4 * p4) * 2;
                const LAS char* vp = lds + G_V + (16 * u + 8 * hi + q4) * GP + (32 * J + 16 * g16 + 4 * p4) * 2;
                const s16x4 k0 = trread(kp), k1 = trread(kp + 4 * GP), v0 = trread(vp), v1 = trread(vp + 4 * GP);
                S = __builtin_amdgcn_mfma_f32_32x32x16_bf16(MK8(k0, k1), MK8(v0, v1), S, 0, 0, 0);
            }
        }
        asm volatile("s_waitcnt lgkmcnt(0)\n\ts_barrier" ::: "memory");
#pragma unroll
        for (int r = 0; r < 16; ++r) ((LAS bf16_t*)(lds + G_SB))[(32 * I + crow(r, hi)) * (GP / 2) + 32 * J + r32] = f2bf(S[r]);
        {
            u32x4 o0v = *(const LAS u32x4*)(lds + G_O + lr * GP + lc * 16), o1v = *(const LAS u32x4*)(lds + G_O + (lr + 32) * GP + lc * 16);
            if (second) {
                o0v.x = cvtpk(bflo(o0v.x) + bflo(prv0.x), bfhi(o0v.x) + bfhi(prv0.x)); o0v.y = cvtpk(bflo(o0v.y) + bflo(prv0.y), bfhi(o0v.y) + bfhi(prv0.y));
                o0v.z = cvtpk(bflo(o0v.z) + bflo(prv0.z), bfhi(o0v.z) + bfhi(prv0.z)); o0v.w = cvtpk(bflo(o0v.w) + bflo(prv0.w), bfhi(o0v.w) + bfhi(prv0.w));
                o1v.x = cvtpk(bflo(o1v.x) + bflo(prv1.x), bfhi(o1v.x) + bfhi(prv1.x)); o1v.y = cvtpk(bflo(o1v.y) + bflo(prv1.y), bfhi(o1v.y) + bfhi(prv1.y));
                o1v.z = cvtpk(bflo(o1v.z) + bflo(prv1.z), bfhi(o1v.z) + bfhi(prv1.z)); o1v.w = cvtpk(bflo(o1v.w) + bflo(prv1.w), bfhi(o1v.w) + bfhi(prv1.w));
            }
            if (!dry) { *(u32x4*)og0 = o0v; *(u32x4*)og1 = o1v; }
        }
    }
    __syncthreads();
#undef GLA_CHUNK
#undef GLA_ROW
#undef GLA_PREFETCH
}

constexpr int PP = 272;
__device__ __forceinline__ void pool_unit(LAS char* lds, int pm, int g, bf16_t* Z, const bf16_t* Wt  , const float* pscale, bool dry) {
    int tid = threadIdx.x; asm volatile("" : "+v"(tid)); const int lane = tid & 63, r32 = lane & 31, hi = lane >> 5; const int wid = __builtin_amdgcn_readfirstlane(tid >> 6);
    const int col = tid & 127, rq = tid >> 7;
    const int half = 1 << g;
    const int tiw = pm % 9; const int L = (tiw == 0) ? CTXL : SEQ; const int t0 = (tiw == 0) ? 0 : (tiw - 1) * 256;
    const bf16_t* ub = Z + (size_t)(pm * 256 - t0) * ZP + ZPX + g * 128;
    LAS char* U = lds + 256 * PP;
    {
        u32x4 uv[9];
#pragma unroll
        for (int k = 0; k < 9; ++k) { const int i = tid + 512 * k; const int j = i >> 4, ch = i & 15; const int t = t0 - 8 + j;
            uv[k] = (u32x4){0u, 0u, 0u, 0u}; if (i < 272 * 16 && t >= 0 && t < L) uv[k] = *(const u32x4*)(ub + (size_t)t * ZP + ch * 8); }
#pragma unroll
        for (int k = 0; k < 9; ++k) { const int i = tid + 512 * k; const int j = i >> 4, ch = i & 15;
            if (i < 272 * 16) *(LAS u32x4*)(U + j * PP + ch * 16) = uv[k]; }
    }
    __syncthreads();
    {
        const LAS bf16_t* uc = (const LAS bf16_t*)U + col;
        const int ts = t0 + rq * 64;
        int lo = ts - half; if (lo < 0) lo = 0; int hiw = ts + half; if (hiw > L) hiw = L;
        float s = 0.f;
        for (int t = lo; t < hiw; ++t) s += bf2f(uc[(t - t0 + 8) * (PP / 2)]);
#pragma unroll 8
        for (int i = 0; i < 64; ++i) {
            const int t = ts + i;
            int l2 = t - half; if (l2 < 0) l2 = 0; int h2 = t + half; if (h2 > L) h2 = L;
            const float ut = bf2f(uc[(t - t0 + 8) * (PP / 2)]);
            const float pv = s * frcp((float)(h2 - l2)) - ut;
            ((LAS bf16_t*)lds)[(rq * 64 + i) * (PP / 2) + col] = f2bf(pv);
            if (t + half < L) s += bf2f(uc[(t + half - t0 + 8) * (PP / 2)]);
            if (t - half >= 0) s -= bf2f(uc[(t - half - t0 + 8) * (PP / 2)]);
        }
    }
    __syncthreads();
    f32x16 acc[4] = {};
#pragma unroll
    for (int s = 0; s < 8; ++s) {
        const bf16x8 a = *(const LAS bf16x8*)(lds + (32 * wid + r32) * PP + (16 * s + 8 * hi) * 2);
#pragma unroll
        for (int n = 0; n < 4; ++n) {
            const bf16x8 bw = *(const bf16x8*)(Wt + (size_t)(32 * n + r32) * 128 + 16 * s + 8 * hi);
            acc[n] = __builtin_amdgcn_mfma_f32_32x32x16_bf16(a, bw, acc[n], 0, 0, 0);
        }
    }
#pragma unroll
    for (int n = 0; n < 4; ++n) { const float sc = pscale[g * 128 + 32 * n + r32];
#pragma unroll
        for (int r = 0; r < 16; ++r) { bf16_t* yp = Z + (size_t)(pm * 256 + 32 * wid + crow(r, hi)) * ZP + ZYP + g * 128 + 32 * n + r32;
            if (!dry) *yp = f2bf(acc[n][r] * sc * bf2f(*yp)); } }
    __syncthreads();
}

__device__ __forceinline__ void prep_item(const Params& p, int l, int mat, int n, int kc, unsigned char* wl) {
    const int k0 = kc * 8; float v[8];
    bf16_t* dst;
    if (mat == 0) {
        dst = (bf16_t*)(wl + W_IN) + (size_t)n * 1024 + k0;
        int col = -1; float sg = 1.f;
        if (n < 256) col = C_MQ + n;
        else if (n < 512) { const int cc = n - 256;
            if (cc < 128) col = C_MKV + cc;
            else if (cc < 192) { const int c2 = cc - 128, g = c2 >> 3, nn = (c2 >> 2) & 1, j = c2 & 3, i = 4 * g + j;
                if (nn == 0) col = C_MKR + i; else { const int i16 = i & 15, base = i & 16; if (i16 < 8) { col = C_MKR + base + i16 + 8; sg = -1.f; } else col = C_MKR + base + i16 - 8; } }
            else if (cc < 208) col = C_AF + cc - 192;
            else if (cc < 224) col = C_AB + cc - 208; }
        else if (n < 1024) col = C_PX + n - 512;
        else if (n < 1280) col = C_GQ + n - 1024;
        else if (n < 1536) col = C_GK + n - 1280;
        else if (n < 2048) col = C_GV + n - 1536;
        else if (n < 2560) col = C_MG + n - 2048;
        else if (n < 3072) col = C_PG + n - 2560;
        else col = C_GG + n - 3072;
        const float* src = p.w_in + (size_t)l * D * DIN;
#pragma unroll
        for (int i = 0; i < 8; ++i) v[i] = (col >= 0) ? sg * src[(size_t)(k0 + i) * DIN + col] : 0.f;
    } else if (mat == 1) {
        dst = (bf16_t*)(wl + W_M) + (size_t)n * 1024 + k0;
        const float* src = p.w_in + (size_t)l * D * DIN + C_MRG + n;
#pragma unroll
        for (int i = 0; i < 8; ++i) v[i] = src[(size_t)(k0 + i) * DIN];
    } else if (mat == 2) {
        dst = (bf16_t*)(wl + W_UQ) + (size_t)n * 256 + k0;
        const int head = n >> 7, cc = n & 127; int col; float sg = 1.f;
        if (cc < 64) col = head * 96 + cc;
        else { const int c2 = cc - 64, g = c2 >> 3, nn = (c2 >> 2) & 1, j = c2 & 3, i = 4 * g + j;
            if (nn == 0) col = head * 96 + 64 + i; else { const int i16 = i & 15, base = i & 16; if (i16 < 8) { col = head * 96 + 64 + base + i16 + 8; sg = -1.f; } else col = head * 96 + 64 + base + i16 - 8; } }
        const float* src = p.mla_w_uq + (size_t)l * 256 * 768 + col; const float* gn = p.mla_q_norm + l * 256;
#pragma unroll
        for (int i = 0; i < 8; ++i) v[i] = sg * gn[k0 + i] * src[(size_t)(k0 + i) * 768];
    } else if (mat == 3) {
        dst = (bf16_t*)(wl + W_UKV) + (size_t)n * 256 + k0;
        const int col = (n < 512) ? ((n >> 6) * 128 + (n & 63)) : (((n - 512) >> 6) * 128 + 64 + (n & 63));
        const float* src = p.mla_w_ukv + (size_t)l * 128 * 1024 + col; const float* gn = p.mla_kv_norm + l * 128;
#pragma unroll
        for (int i = 0; i < 8; ++i) v[i] = (k0 < 128) ? gn[k0 + i] * src[(size_t)(k0 + i) * 1024] : 0.f;
    } else if (mat == 4) {
        dst = (bf16_t*)(wl + W_BR) + (size_t)n * 1536 + k0;
        const int br = k0 >> 9, kk = k0 & 511;
        const float* src = (br == 0 ? p.w_bm : (br == 1 ? p.w_bp : p.w_bg)) + (size_t)l * 512 * 1024 + n;
#pragma unroll
        for (int i = 0; i < 8; ++i) v[i] = src[(size_t)(kk + i) * 1024];
    } else if (mat == 5) {
        dst = (bf16_t*)(wl + W_OUT) + (size_t)n * 1024 + k0;
        const float* src = p.w_out + (size_t)l * 1024 * 1024 + n;
#pragma unroll
        for (int i = 0; i < 8; ++i) v[i] = src[(size_t)(k0 + i) * 1024];
    } else {
        dst = (bf16_t*)(wl + W_POOL) + (size_t)n * 128 + k0;
        const int g = n >> 7, o = n & 127;
        const float* src = p.pool_w + (size_t)l * 4 * 128 * 128 + (size_t)g * 128 * 128 + o;
#pragma unroll
        for (int i = 0; i < 8; ++i) v[i] = src[(size_t)(k0 + i) * 128];
    }
    u32x4 o; o.x = cvtpk(v[0], v[1]); o.y = cvtpk(v[2], v[3]); o.z = cvtpk(v[4], v[5]); o.w = cvtpk(v[6], v[7]);
    *(u32x4*)dst = o;
}

__device__ __forceinline__ void modnorm_row(const float* xr, const float* pre_g, const float* modrow, bf16_t* hrow, int l32) {
    f32x4 v[8]; float s = 0.f;
#pragma unroll
    for (int j = 0; j < 4; ++j) { v[2 * j] = *(const f32x4*)(xr + 8 * l32 + 256 * j); v[2 * j + 1] = *(const f32x4*)(xr + 8 * l32 + 256 * j + 4); }
#pragma unroll
    for (int j = 0; j < 8; ++j) s += v[j][0] * v[j][0] + v[j][1] * v[j][1] + v[j][2] * v[j][2] + v[j][3] * v[j][3];
#pragma unroll
    for (int o = 1; o < 32; o <<= 1) s += __shfl_xor(s, o);
    const float rs = __builtin_amdgcn_rsqf(s * (1.f / D) + EPS);
#pragma unroll
    for (int j = 0; j < 4; ++j) { float o[8];
#pragma unroll
        for (int q = 0; q < 2; ++q) { const int c = 8 * l32 + 256 * j + 4 * q;
            const f32x4 g = *(const f32x4*)(pre_g + c), sh = *(const f32x4*)(modrow + c), sc = *(const f32x4*)(modrow + D + c);
#pragma unroll
            for (int e = 0; e < 4; ++e) o[4 * q + e] = v[2 * j + q][e] * rs * g[e] * (1.f + sc[e]) + sh[e]; }
        u32x4 pk; pk.x = cvtpk(o[0], o[1]); pk.y = cvtpk(o[2], o[3]); pk.z = cvtpk(o[4], o[5]); pk.w = cvtpk(o[6], o[7]);
        *(u32x4*)(hrow + 8 * l32 + 256 * j) = pk; }
}

__global__ void __launch_bounds__(512, 2) fwd_kernel(Params p) {
    extern __shared__ __attribute__((aligned(16))) unsigned char lds_raw[];
    LAS unsigned char* lds = (LAS unsigned char*)lds_raw;
    cg::grid_group grid = cg::this_grid();
    const int wid = __builtin_amdgcn_readfirstlane(threadIdx.x >> 6);
    const int G = gridDim.x, bid = blockIdx.x;
    const int vcu = (G % 8 == 0) ? (bid % 8) * (G / 8) + bid / 8 : bid;
    const int gw = bid * 8 + wid, NGW = G * 8;
    unsigned char* ws = p.ws;
    bf16_t* Z = (bf16_t*)(ws + OFF_Z); bf16_t* H = (bf16_t*)(ws + OFF_H); bf16_t* Qb = (bf16_t*)(ws + OFF_Q); bf16_t* KVb = (bf16_t*)(ws + OFF_KV);
    bf16_t* OT = (bf16_t*)(ws + OFF_OT); bf16_t* KR = (bf16_t*)(ws + OFF_KR);
    float* ssq_q = (float*)(ws + OFF_SSQQ); float* ssq_kv = (float*)(ws + OFF_SSQKV); float* modb = (float*)(ws + OFF_MOD); f32x2* tab = (f32x2*)(ws + OFF_TAB);
    const int lo = p.ph_lo, hi_ph = p.ph_hi; const bool dryflag = (p.ph_lo == 0);
    unsigned* barw = (unsigned*)(ws + OFF_BAR);
    XcdBarrier xbar; xbar.bar = barw; xbar.x = 0; xbar.st = (volatile LAS unsigned*)(lds + 147200);
    if (threadIdx.x < 2) ((volatile LAS unsigned*)(lds + 147200))[threadIdx.x] = 0u;
    if (bid == 0) for (int i = threadIdx.x; i < XCD_BAR_WORDS; i += 512) barw[i] = 0u;
    int ph = 0;
#define PHASE_BEGIN if (ph >= lo && ph < hi_ph) { int tid = threadIdx.x; asm volatile("" : "+v"(tid)); const int lane = tid & 63; (void)lane;
#define PHASE_END } ++ph; if (ph > lo && ph < hi_ph) { if (ph == 1) { grid.sync(); xbar = xcd_barrier_post(barw, (volatile LAS unsigned*)(lds + 147200)); } else { xcd_barrier(xbar); if (DUP == 12) { xcd_barrier(xbar); xcd_barrier(xbar); xcd_barrier(xbar); xcd_barrier(xbar); } } }

    PHASE_BEGIN
    for (int rep = (DUP == 10 ? 0 : 1); rep < 2; ++rep) {
        const long gt = (long)bid * 512 + tid, NT = (long)G * 512;
        for (int l = 0; l < 2; ++l) {
            unsigned char* wl = ws + OFF_W + (size_t)l * W_LAYER;
            for (long it = gt; it < 3584L * 128; it += NT) prep_item(p, l, 0, (int)(it % 3584), (int)(it / 3584), wl);
            for (long it = gt; it < 3072L * 128; it += NT) prep_item(p, l, 1, (int)(it % 3072), (int)(it / 3072), wl);
            for (long it = gt; it < 1024L * 32; it += NT) prep_item(p, l, 2, (int)(it % 1024), (int)(it / 1024), wl);
            for (long it = gt; it < 1024L * 32; it += NT) prep_item(p, l, 3, (int)(it % 1024), (int)(it / 1024), wl);
            for (long it = gt; it < 1024L * 192; it += NT) prep_item(p, l, 4, (int)(it % 1024), (int)(it / 1024), wl);
            for (long it = gt; it < 1024L * 128; it += NT) prep_item(p, l, 5, (int)(it % 1024), (int)(it / 1024), wl);
            for (long it = gt; it < 512L * 16; it += NT) prep_item(p, l, 6, (int)(it % 512), (int)(it / 512), wl);
        }
        if (gt < 512) { const int pos = (int)gt >> 3, f = (int)gt & 7; const float inv = exp2f(-(float)f * (13.287712379549449f / 8.f));
            const float rev = (float)pos * inv * 0.15915494309189535f; const float fr_ = rev - floorf(rev);
            f32x2 e; e.x = __builtin_amdgcn_cosf(fr_); e.y = __builtin_amdgcn_sinf(fr_); tab[gt] = e; }
        for (long i = gt; i < M; i += NT) { ssq_q[i] = 0.f; ssq_kv[i] = 0.f; }
        LAS float* sc = (LAS float*)lds;
        for (int i = tid; i < 33 * 1024; i += 512) { const int bb = i >> 10, k = i & 1023; const float cv = (bb < 32) ? p.c[bb * 1024 + k] : p.c_ctx[k]; sc[i] = cv / (1.f + __expf(-cv)); }
        __syncthreads();
        for (int u = bid; u < 192; u += G) {
            const int l = u / 96, cgp = u % 96; const int colq = tid & 31, kg = tid >> 5;
            float a[33];
#pragma unroll
            for (int bb = 0; bb < 33; ++bb) a[bb] = 0.f;
            const float* wp = p.mod_w + (size_t)l * 1024 * 3072 + cgp * 32 + colq;
            for (int k0 = kg * 64; k0 < kg * 64 + 64; k0 += 8) { float w8[8];
#pragma unroll
                for (int q = 0; q < 8; ++q) w8[q] = wp[(size_t)(k0 + q) * 3072];
#pragma unroll
                for (int q = 0; q < 8; ++q)
#pragma unroll
                    for (int bb = 0; bb < 33; ++bb) a[bb] += sc[bb * 1024 + k0 + q] * w8[q]; }
            LAS float* red = (LAS float*)(lds + 135168);
            for (int i = tid; i < 33 * 32; i += 512) red[i] = 0.f;
            __syncthreads();
#pragma unroll
            for (int bb = 0; bb < 33; ++bb) atomicAdd((float*)(red + bb * 32 + colq), a[bb]);
            __syncthreads();
            for (int i = tid; i < 33 * 32; i += 512) { const int bb = i >> 5, cq = i & 31; modb[((size_t)l * 33 + bb) * 3072 + cgp * 32 + cq] = red[i] + p.mod_b[l * 3072 + cgp * 32 + cq]; }
            __syncthreads();
        }
    }
    PHASE_END

    PHASE_BEGIN
    for (int rep = (DUP == 9 ? 0 : 1); rep < 2; ++rep)
    for (int r0 = 2 * gw; r0 < M; r0 += 2 * NGW) { const int r = r0 + (lane >> 5);
        const int b = r / TOK, tok = r % TOK;
        const float* xr = (tok < CTXL) ? p.ctx + ((size_t)b * CTXL + tok) * D : p.x + ((size_t)b * SEQ + tok - CTXL) * D;
        modnorm_row(xr, p.pre_norm, modb + (size_t)((tok < CTXL) ? 32 : b) * 3072, H + (size_t)r * D, lane & 31);
    }
    PHASE_END

    for (int l = 0; l < 2; ++l) {
        unsigned char* wl = ws + OFF_W + (size_t)l * W_LAYER;
        GEpi E; E.Z = Z; E.KR = KR; E.ssq_q = ssq_q; E.ssq_kv = ssq_kv; E.Qb = Qb; E.KVb = KVb; E.gscr = ws + OFF_Q + (size_t)bid * GSCR_PER_WG; E.tab = tab;
        GSched S; S.G = G; S.c = bid; S.Z = (const char*)Z; S.H = (const char*)H; S.W = (const char*)wl;

        PHASE_BEGIN
        S.mode = 0; S.latent_only = (l == 1);
        if (DUP == 1) gemm_phase(lds, S, E, dryflag);
        gemm_phase(lds, S, E, false);
        PHASE_END

        PHASE_BEGIN
        for (int rep = (DUP == 2 ? 0 : 1); rep < 2; ++rep)
        for (int u = vcu; u < 256; u += G) {
            const int b = u >> 3, h = (u >> 1) & 3, dvh = u & 1;
            gla_unit((LAS char*)lds, b, h, dvh, Z, OT, p.af_w2 + l * 16 * 256, p.af_b + l * 256, p.ab_w2 + l * 16 * 256, p.ab_b + l * 256, rep == 0 && dryflag);
        }
        __syncthreads();
        S.mode = 1; S.latent_only = (l == 1);
        if (DUP == 3) gemm_phase(lds, S, E, dryflag);
        gemm_phase(lds, S, E, false);
        for (int rep = (DUP == 4 ? 0 : 1); rep < 2; ++rep)
        for (int u = vcu; u < 288 * 4; u += G) { const int pm = u >> 2, g = u & 3;
            if (l == 1 && pm % 9 == 0) continue;
            pool_unit((LAS char*)lds, pm, g, Z, (const bf16_t*)(wl + W_POOL) + (size_t)g * 128 * 128, p.pool_scale + l * 512, rep == 0 && dryflag); }
        PHASE_END

        PHASE_BEGIN
        for (int rep = (DUP == 11 ? 0 : 1); rep < 2; ++rep)
        for (int r0 = 4 * gw; r0 < M; r0 += 4 * NGW) {
            if (l == 1 && (r0 % TOK) < CTXL) continue;
            const int r = r0 + (lane >> 4), l16 = lane & 15;
            u32x4 ov[4], gv[4];
#pragma unroll
            for (int hh = 0; hh < 4; ++hh) { ov[hh] = *(const u32x4*)(OT + (size_t)r * 512 + hh * 128 + 8 * l16); gv[hh] = *(const u32x4*)(Z + (size_t)r * ZP + ZYG + hh * 128 + 8 * l16); }
            const f32x4 gn0 = *(const f32x4*)(p.gla_norm + l * 128 + 8 * l16), gn1 = *(const f32x4*)(p.gla_norm + l * 128 + 8 * l16 + 4);
#pragma unroll
            for (int hh = 0; hh < 4; ++hh) {
                float o[8] = {bflo(ov[hh].x), bfhi(ov[hh].x), bflo(ov[hh].y), bfhi(ov[hh].y), bflo(ov[hh].z), bfhi(ov[hh].z), bflo(ov[hh].w), bfhi(ov[hh].w)};
                float s = 0.f;
#pragma unroll
                for (int j = 0; j < 8; ++j) s += o[j] * o[j];
                s += __shfl_xor(s, 1); s += __shfl_xor(s, 2); s += __shfl_xor(s, 4); s += __shfl_xor(s, 8);
                const float rs = __builtin_amdgcn_rsqf(s * (1.f / 128.f) + EPS);
                const float gt[8] = {bflo(gv[hh].x), bfhi(gv[hh].x), bflo(gv[hh].y), bfhi(gv[hh].y), bflo(gv[hh].z), bfhi(gv[hh].z), bflo(gv[hh].w), bfhi(gv[hh].w)};
                u32x4 ow; ow.x = cvtpk(o[0] * rs * gn0[0] * gt[0], o[1] * rs * gn0[1] * gt[1]); ow.y = cvtpk(o[2] * rs * gn0[2] * gt[2], o[3] * rs * gn0[3] * gt[3]);
                ow.z = cvtpk(o[4] * rs * gn1[0] * gt[4], o[5] * rs * gn1[1] * gt[5]); ow.w = cvtpk(o[6] * rs * gn1[2] * gt[6], o[7] * rs * gn1[3] * gt[7]);
                if (!(rep == 0 && dryflag)) *(u32x4*)(Z + (size_t)r * ZP + ZYG + hh * 128 + 8 * l16) = ow;
            }
        }
        __syncthreads();
        {
            const int nlat = 2048, nctx = (l == 0) ? 256 : 0;
            for (int rep = (DUP == 5 ? 0 : 1); rep < 2; ++rep)
            for (int u = vcu; u < nlat + nctx; u += G) { const bool dry = (rep == 0) && dryflag;
                if (u < nlat) { const int bh = u >> 3, qb = u & 7, b = bh >> 3, h = bh & 7; const size_t q0 = (size_t)b * TOK + CTXL + qb * 256, k0 = (size_t)b * TOK;
                    attn_unit((LAS char*)lds, Qb + q0 * 768 + h * 96, KVb + k0 * 1024 + h * 64, KR + k0 * 32, 36, Z + q0 * ZP + ZYM + h * 64, dry); }
                else { const int bh = u - nlat, b = bh >> 3, h = bh & 7; const size_t q0 = (size_t)b * TOK;
                    attn_unit((LAS char*)lds, Qb + q0 * 768 + h * 96, KVb + q0 * 1024 + h * 64, KR + q0 * 32, 4, Z + q0 * ZP + ZYM + h * 64, dry); }
            }
        }
        PHASE_END

        PHASE_BEGIN
        S.mode = 2; S.latent_only = (l == 1);
        if (DUP == 6) gemm_phase(lds, S, E, dryflag);
        if (DUP == 13) gemm_phase(lds, S, E, !dryflag);
        gemm_phase(lds, S, E, false);
        PHASE_END

        PHASE_BEGIN
        S.mode = 3; S.latent_only = (l == 1);
        if (DUP == 7) gemm_phase(lds, S, E, dryflag);
        gemm_phase(lds, S, E, false);
        PHASE_END

        PHASE_BEGIN
        for (int rep = (DUP == 8 ? 0 : 1); rep < 2; ++rep)
        for (int r0 = 2 * gw; r0 < M; r0 += 2 * NGW) { const bool dry = (rep == 0) && dryflag;
            const int l32 = lane & 31; const int r = r0 + (lane >> 5);
            const int b = r / TOK, tok = r % TOK; const bool isctx = tok < CTXL;
            if (l == 1 && (r0 % TOK) < CTXL) continue;
            const bf16_t* orow = Z + (size_t)r * ZP + 1024;
            const float* xr = (l == 0) ? (isctx ? p.ctx + ((size_t)b * CTXL + tok) * D : p.x + ((size_t)b * SEQ + tok - CTXL) * D) : p.out + ((size_t)b * SEQ + tok - CTXL) * D;
            const float* mrow = modb + ((size_t)l * 33 + (isctx ? 32 : b)) * 3072;
            u32x4 t4[4]; f32x4 xv[8];
#pragma unroll
            for (int j = 0; j < 4; ++j) { t4[j] = *(const u32x4*)(orow + 8 * l32 + 256 * j); xv[2 * j] = *(const f32x4*)(xr + 8 * l32 + 256 * j); xv[2 * j + 1] = *(const f32x4*)(xr + 8 * l32 + 256 * j + 4); }
            float ov[32]; float s = 0.f;
#pragma unroll
            for (int j = 0; j < 4; ++j) {
                ov[8 * j + 0] = bflo(t4[j].x); ov[8 * j + 1] = bfhi(t4[j].x); ov[8 * j + 2] = bflo(t4[j].y); ov[8 * j + 3] = bfhi(t4[j].y); ov[8 * j + 4] = bflo(t4[j].z); ov[8 * j + 5] = bfhi(t4[j].z); ov[8 * j + 6] = bflo(t4[j].w); ov[8 * j + 7] = bfhi(t4[j].w); }
#pragma unroll
            for (int j = 0; j < 32; ++j) s += ov[j] * ov[j];
#pragma unroll
            for (int o = 1; o < 32; o <<= 1) s += __shfl_xor(s, o);
            const float rs = __builtin_amdgcn_rsqf(s * (1.f / D) + EPS);
            float s2 = 0.f;
#pragma unroll
            for (int j = 0; j < 4; ++j)
#pragma unroll
                for (int q = 0; q < 2; ++q) { const int c = 8 * l32 + 256 * j + 4 * q;
                    const f32x4 pg = *(const f32x4*)(p.post_norm + l * D + c), gt = *(const f32x4*)(mrow + 2 * D + c);
#pragma unroll
                    for (int e = 0; e < 4; ++e) { const float v = xv[2 * j + q][e] + gt[e] * ov[8 * j + 4 * q + e] * rs * pg[e]; ov[8 * j + 4 * q + e] = v; s2 += v * v; } }
            if (!isctx && !dry) { float* orw = p.out + ((size_t)b * SEQ + tok - CTXL) * D;
#pragma unroll
                for (int j = 0; j < 4; ++j)
#pragma unroll
                    for (int q = 0; q < 2; ++q) *(f32x4*)(orw + 8 * l32 + 256 * j + 4 * q) = (f32x4){ov[8 * j + 4 * q], ov[8 * j + 4 * q + 1], ov[8 * j + 4 * q + 2], ov[8 * j + 4 * q + 3]}; }
            if (l == 0) {
#pragma unroll
                for (int o = 1; o < 32; o <<= 1) s2 += __shfl_xor(s2, o);
                if (!dry) {
                const float rs2 = __builtin_amdgcn_rsqf(s2 * (1.f / D) + EPS);
                const float* m1 = modb + ((size_t)33 + (isctx ? 32 : b)) * 3072;
#pragma unroll
                for (int j = 0; j < 4; ++j) { float hv[8];
#pragma unroll
                    for (int q = 0; q < 2; ++q) { const int c = 8 * l32 + 256 * j + 4 * q;
                        const f32x4 g = *(const f32x4*)(p.pre_norm + D + c), sh = *(const f32x4*)(m1 + c), scl = *(const f32x4*)(m1 + D + c);
#pragma unroll
                        for (int e = 0; e < 4; ++e) hv[4 * q + e] = ov[8 * j + 4 * q + e] * rs2 * g[e] * (1.f + scl[e]) + sh[e]; }
                    u32x4 hw; hw.x = cvtpk(hv[0], hv[1]); hw.y = cvtpk(hv[2], hv[3]); hw.z = cvtpk(hv[4], hv[5]); hw.w = cvtpk(hv[6], hv[7]);
                    *(u32x4*)(H + (size_t)r * D + 8 * l32 + 256 * j) = hw; }
                if (l32 == 0) { ssq_q[r] = 0.f; ssq_kv[r] = 0.f; }
                }
            }
        }
        PHASE_END
    }
}

extern "C" void kernel_launch(void* const* d_in, const int* in_sizes, int n_in, void* d_out, int out_size, void* d_ws, size_t ws_size, hipStream_t stream) {
    static int grid = 0;
    if (grid == 0) {
        if (n_in != 24 || ws_size < WS_END) { fprintf(stderr, "kernel_launch: bad inputs n_in=%d ws=%zu need %zu\n", n_in, ws_size, (size_t)WS_END); grid = -1; return; }
        int dev = 0, cus = 0, per_cu = 0;
        hipGetDevice(&dev); hipDeviceGetAttribute(&cus, hipDeviceAttributeMultiprocessorCount, dev);
        hipFuncSetAttribute((const void*)fwd_kernel, hipFuncAttributeMaxDynamicSharedMemorySize, LDS_BYTES);
        hipOccupancyMaxActiveBlocksPerMultiprocessor(&per_cu, (const void*)fwd_kernel, 512, LDS_BYTES);
        if (per_cu < 1) { fprintf(stderr, "kernel_launch: occupancy query returned %d\n", per_cu); per_cu = 1; }
        (void)hipGetLastError();
        grid = cus < 256 ? cus : 256;
    }
    if (grid < 0) return;
    Params p{};
    const float** f = (const float**)&p;
    for (int i = 0; i < 24; ++i) f[i] = (const float*)d_in[i];
    p.out = (float*)d_out; p.ws = (unsigned char*)d_ws; p.ph_lo = 0; p.ph_hi = 1000;
    void* args[] = {&p};
    hipError_t e = hipLaunchCooperativeKernel((const void*)fwd_kernel, dim3(grid), dim3(512), args, LDS_BYTES, stream);
    if (e != hipSuccess) fprintf(stderr, "cooperative launch failed: %s (grid %d)\n", hipGetErrorString(e), grid);
}
```

```cpp
#include <hip/hip_runtime.h>
#include <hip/hip_cooperative_groups.h>
#include <cstdio>
#include <cstdint>
namespace cg = cooperative_groups;

#define LAS __attribute__((address_space(3)))
typedef unsigned short bf16_t;
typedef short bf16x8 __attribute__((ext_vector_type(8)));
typedef short s16x4 __attribute__((ext_vector_type(4)));
typedef float f32x4 __attribute__((ext_vector_type(4)));
typedef float f32x2 __attribute__((ext_vector_type(2)));
typedef float f32x16 __attribute__((ext_vector_type(16)));
typedef unsigned u32x4 __attribute__((ext_vector_type(4)));
typedef unsigned u32x2 __attribute__((ext_vector_type(2)));
typedef __bf16 bf16x2_t __attribute__((ext_vector_type(2)));

constexpr int NB = 32, SEQ = 2048, CTXL = 256, TOK = 2304, M = NB * TOK, D = 1024, DIN = 6592, ZP = 3584;
constexpr int ZQ = 0, ZKV = 256, ZPX = 512, ZGQ = 1024, ZGK = 1280, ZGV = 1536, ZYM = 2048, ZYP = 2560, ZYG = 3072;
constexpr int ZAF = ZKV + 192, ZAB = ZKV + 208;
constexpr float EPS = 1e-6f;
constexpr float QSCALE = 0.10206207261596577f * 1.4426950408889634f;
constexpr int C_MQ = 0, C_MKV = 256, C_MKR = 384, C_MG = 416, C_PX = 928, C_PG = 1440, C_GQ = 1952, C_GK = 2208, C_GV = 2464, C_AF = 2976, C_AB = 2992, C_GG = 3008, C_MRG = 3520;

constexpr size_t SZ_Z = (size_t)M * ZP * 2, SZ_H = (size_t)M * D * 2, SZ_Q = (size_t)M * 768 * 2, SZ_KV = (size_t)M * 1024 * 2, SZ_OT = (size_t)M * 512 * 2, SZ_KR = (size_t)M * 32 * 2;
constexpr size_t OFF_Z = 0, OFF_H = OFF_Z + SZ_Z, OFF_Q = OFF_H + SZ_H, OFF_KV = OFF_Q + SZ_Q, OFF_OT = OFF_KV + SZ_KV, OFF_KR = OFF_OT + SZ_OT, OFF_W = OFF_KR + SZ_KR;
constexpr size_t W_IN = 0, W_M = W_IN + 3584 * 1024 * 2, W_UQ = W_M + 3072 * 1024 * 2, W_UKV = W_UQ + 1024 * 256 * 2, W_BR = W_UKV + 1024 * 256 * 2, W_OUT = W_BR + 1024 * 1536 * 2, W_POOL = W_OUT + 1024 * 1024 * 2, W_LAYER = W_POOL + 4 * 128 * 128 * 2;
constexpr size_t OFF_SSQQ = OFF_W + 2 * W_LAYER, OFF_SSQKV = OFF_SSQQ + (size_t)M * 4, OFF_MOD = OFF_SSQKV + (size_t)M * 4, OFF_TAB = OFF_MOD + 2 * 33 * 3072 * 4, OFF_BAR = OFF_TAB + 64 * 8 * 8, WS_END = OFF_BAR + 16384;
constexpr size_t GSCR_PER_WG = 3 * 16 * 512 * 16;
static_assert(256 * GSCR_PER_WG <= SZ_Q, "gate scratch overlays Q");
static_assert(WS_END <= (size_t)1 << 30, "workspace");

constexpr int LDS_BYTES = 147456;
#ifndef DUP
#define DUP 0
#endif

__device__ __forceinline__ unsigned cvtpk(float lo, float hi) { f32x2 v = {lo, hi}; bf16x2_t b = __builtin_convertvector(v, bf16x2_t); return __builtin_bit_cast(unsigned, b); }
__device__ __forceinline__ bf16_t f2bf(float f) { return (bf16_t)(cvtpk(f, 0.f) & 0xffffu); }
__device__ __forceinline__ float bf2f(bf16_t b) { return __uint_as_float(((unsigned)b) << 16); }
__device__ __forceinline__ float bflo(unsigned u) { return __uint_as_float(u << 16); }
__device__ __forceinline__ float bfhi(unsigned u) { return __uint_as_float(u & 0xffff0000u); }
__device__ __forceinline__ float fexp2(float x) { return __builtin_amdgcn_exp2f(x); }
__device__ __forceinline__ float fexp(float x) { return __builtin_amdgcn_exp2f(x * 1.4426950408889634f); }
__device__ __forceinline__ float frcp(float x) { return __builtin_amdgcn_rcpf(x); }
__device__ __forceinline__ float sigmoidf_(float x) { return frcp(1.f + fexp(-x)); }
__device__ __forceinline__ float siluf_(float x) { return x * sigmoidf_(x); }
__device__ __forceinline__ float wave_sum(float v) {
#pragma unroll
    for (int o = 1; o < 64; o <<= 1) v += __shfl_xor(v, o);
    return v;
}
__device__ __forceinline__ int crow(int r, int hi) { return (r & 3) + 8 * (r >> 2) + 4 * hi; }
__device__ __forceinline__ u32x4 pack8(f32x4 a, f32x4 b) { u32x4 o; o.x = cvtpk(a[0], a[1]); o.y = cvtpk(a[2], a[3]); o.z = cvtpk(b[0], b[1]); o.w = cvtpk(b[2], b[3]); return o; }
__device__ __forceinline__ s16x4 trread(const LAS char* p) { return __builtin_bit_cast(s16x4, __builtin_amdgcn_ds_read_tr16_b64_v4i16((LAS s16x4*)p)); }
#define MK8(lo, hi) (bf16x8){lo[0], lo[1], lo[2], lo[3], hi[0], hi[1], hi[2], hi[3]}


#define XB_TMO      128
#define XB_XCNT(j)  (256  + 64 * (j))
#define XB_XSUB(j)  (1280 + 64 * (j))
#define XB_XGEN(j)  (2304 + 64 * (j))
#define XB_TOP      3328
#define XB_TOPGEN   3392
#define XCD_BAR_WORDS 3456
#define XB_SPIN_CAP (1u << 18)
__device__ __forceinline__ unsigned xb_ld(unsigned* p)              { return __hip_atomic_load(p, __ATOMIC_RELAXED, __HIP_MEMORY_SCOPE_AGENT); }
__device__ __forceinline__ unsigned xb_add(unsigned* p, unsigned v) { return __hip_atomic_fetch_add(p, v, __ATOMIC_RELAXED, __HIP_MEMORY_SCOPE_AGENT); }
__device__ __forceinline__ unsigned xb_xcc_id() { return (unsigned)__builtin_amdgcn_s_getreg((3 << 11) | 20) & 0xFu; }
#define XB_SPIN(cond, bar) do { unsigned _sp = 0; while (cond) { __builtin_amdgcn_s_sleep(1); \
    if ((++_sp & 255u) == 0u) { if (xb_ld(&(bar)[XB_TMO])) break; if (_sp > XB_SPIN_CAP) { atomicAdd(&(bar)[XB_TMO], 1u); break; } } } } while (0)
struct XcdBarrier { unsigned* bar; unsigned x; volatile LAS unsigned* st; };
__device__ __forceinline__ XcdBarrier xcd_barrier_post(unsigned* bar, volatile LAS unsigned* st) {
    XcdBarrier b; b.bar = bar; b.x = xb_xcc_id(); b.st = st;
    if (threadIdx.x == 0) (void)xb_add(&bar[XB_XCNT(b.x)], 1u);
    return b;
}
__device__ __forceinline__ void xcd_barrier_complete(unsigned* bar, unsigned x, unsigned& nloc, unsigned& nx) {
    const unsigned G = gridDim.x * gridDim.y * gridDim.z;
    unsigned sum, cnt, mine, sp = 0u;
    for (;;) {
        sum = 0u; cnt = 0u; mine = 0u;
#pragma unroll
        for (unsigned j = 0; j < 16; ++j) { const unsigned c = xb_ld(&bar[XB_XCNT(j)]); sum += c; cnt += (c > 0u) ? 1u : 0u; mine = (j == x) ? c : mine; }
        if (sum == G) break;
        __builtin_amdgcn_s_sleep(1);
        if ((++sp & 255u) == 0u) { if (xb_ld(&bar[XB_TMO])) break; if (sp > XB_SPIN_CAP) { atomicAdd(&bar[XB_TMO], 1u); break; } }
    }
    nloc = mine > 0u ? mine : 1u; nx = cnt > 0u ? cnt : 1u;
}
__device__ __forceinline__ void xcd_barrier(const XcdBarrier& b) {
    asm volatile("s_waitcnt vmcnt(0)" ::: "memory");
    __syncthreads();
    if (threadIdx.x == 0) {
        unsigned* bar = b.bar;
        __builtin_amdgcn_s_waitcnt(0);
        unsigned nloc = b.st[0], nx = b.st[1];
        if (nloc == 0u) { xcd_barrier_complete(bar, b.x, nloc, nx); b.st[0] = nloc; b.st[1] = nx; }
        const unsigned old = xb_add(&bar[XB_XSUB(b.x)], 1u);
        const unsigned gen = old / nloc;
        if (old + 1u == (gen + 1u) * nloc) {
            __builtin_amdgcn_fence(__ATOMIC_RELEASE, "agent");
            asm volatile("s_waitcnt vmcnt(0)" ::: "memory");
            const unsigned og = xb_add(&bar[XB_TOP], 1u);
            const unsigned tg = og / nx;
            if (og + 1u == (tg + 1u) * nx) xb_add(&bar[XB_TOPGEN], 1u);
            else XB_SPIN(xb_ld(&bar[XB_TOPGEN]) == tg, bar);
            __builtin_amdgcn_fence(__ATOMIC_ACQUIRE, "agent");
            xb_add(&bar[XB_XGEN(b.x)], 1u);
            asm volatile("s_waitcnt vmcnt(0)" ::: "memory");
        } else {
            XB_SPIN(xb_ld(&bar[XB_XGEN(b.x)]) == gen, bar);
            __builtin_amdgcn_fence(__ATOMIC_ACQUIRE, "agent");
            asm volatile("s_waitcnt vmcnt(0)" ::: "memory");
        }
    }
    __syncthreads();
}

struct Params {
    const float* x; const float* c; const float* ctx; const float* c_ctx; const float* mod_w; const float* mod_b; const float* pre_norm; const float* post_norm;
    const float* w_in; const float* mla_q_norm; const float* mla_w_uq; const float* mla_kv_norm; const float* mla_w_ukv; const float* pool_w; const float* pool_scale;
    const float* af_w2; const float* af_b; const float* ab_w2; const float* ab_b; const float* gla_norm; const float* w_bm; const float* w_bp; const float* w_bg; const float* w_out;
    float* out; unsigned char* ws; int ph_lo, ph_hi;
};

constexpr int BK = 64, HALF = 128, HTB = HALF * BK * 2;
__device__ __forceinline__ int lds_byte(int r, int c) { const int st = (r >> 4) * 2 + (c >> 5), rr = r & 15, cc = c & 31, ob = rr * 64 + cc * 2; return st * 1024 + (ob ^ (((ob >> 9) & 1) << 5)); }
__device__ __forceinline__ void stage_rc(int b, int& R, int& C) { const int st = b / 1024, sb = b % 1024, swz = sb ^ (((sb >> 9) & 1) << 5); R = (st >> 1) * 16 + swz / 64; C = (st & 1) * 32 + (swz % 64) / 2; }
__device__ __forceinline__ int perm32(int rho) { const int n = rho >> 4, i = rho & 15; return 8 * (i >> 2) + 4 * n + (i & 3); }

enum { EP_ZIN = 0, EP_Q = 1, EP_KV = 2, EP_GATE = 3, EP_MERGE = 4, EP_OUT = 5 };
struct GUnit { const char* A; const char* B; int lda2; int nt; int kind; int pm; int pn; int aux; };

__device__ __forceinline__ bool tile_of(long L, int nM, int nN, int& pm, int& pn) {
    const int nwg = nM * nN; if (L >= nwg) return false;
    int wgid = (int)L; { const int q = nwg / 8, r = nwg % 8, xcd = wgid % 8, off = wgid / 8; wgid = (xcd < r ? xcd * (q + 1) : r * (q + 1) + (xcd - r) * q) + off; }
    const int nig = 8 * nN, gid = wgid / nig, fm = gid * 8, gsz = (nM - fm) < 8 ? (nM - fm) : 8;
    pm = fm + ((wgid % nig) % gsz); pn = (wgid % nig) / gsz; return true;
}

struct GSched {
    int mode;
    int G, c; int latent_only;
    const char* Z; const char* H; const char* W;
    __device__ __forceinline__ int rowtile(int lt) const { return latent_only ? ((lt >> 3) * 9 + 1 + (lt & 7)) : lt; }
    __device__ __forceinline__ int nrt() const { return latent_only ? 256 : 288; }
    __device__ __forceinline__ bool next(int i, GUnit& u) const {
        int pm, pn;
        if (mode == 0) {
            if (latent_only) {
                const long L = (long)i * G + c;
                if (L < 256 * 14) { tile_of(L, 256, 14, pm, pn); pm = rowtile(pm); }
                else { const int L2 = (int)(L - 256 * 14); if (L2 >= 128) return false; pm = (L2 >> 2) * 9; const int q = L2 & 3; pn = (q == 0) ? 1 : (4 + q); }
            } else
            if (!tile_of((long)i * G + c, 288, 14, pm, pn)) return false;
            u.A = H + (size_t)pm * 256 * 2048; u.lda2 = 2048; u.B = W + W_IN + (size_t)pn * 256 * 2048; u.nt = 16; u.kind = EP_ZIN; u.pm = pm; u.pn = pn; u.aux = 0; return true;
        } else if (mode == 1) {
            const long L = (long)i * G + c; const int nq = nrt() * 4;
            if (L < nq) { tile_of(L, nrt(), 4, pm, pn); pm = rowtile(pm);
                u.A = Z + (size_t)pm * 256 * (ZP * 2) + ZQ * 2; u.lda2 = ZP * 2; u.B = W + W_UQ + (size_t)pn * 256 * 512; u.nt = 4; u.kind = EP_Q; u.pm = pm; u.pn = pn; u.aux = 0; return true; }
            if (!tile_of(L - nq, 288, 4, pm, pn)) return false;
            u.A = Z + (size_t)pm * 256 * (ZP * 2) + ZKV * 2; u.lda2 = ZP * 2; u.B = W + W_UKV + (size_t)pn * 256 * 512; u.nt = 4; u.kind = EP_KV; u.pm = pm; u.pn = pn; u.aux = 0; return true;
        } else if (mode == 2) {
            const int grp = i >> 2, sub = i & 3;
            if (!tile_of((long)grp * G + c, nrt(), 4, pm, pn)) return false;
            pm = rowtile(pm); u.pm = pm; u.pn = pn; u.aux = sub;
            if (sub < 3) { u.A = H + (size_t)pm * 256 * 2048; u.lda2 = 2048; u.B = W + W_M + (size_t)(sub * 1024 + pn * 256) * 2048; u.nt = 16; u.kind = EP_GATE; }
            else { u.A = Z + (size_t)pm * 256 * (ZP * 2) + ZYM * 2; u.lda2 = ZP * 2; u.B = W + W_BR + (size_t)pn * 256 * 3072; u.nt = 24; u.kind = EP_MERGE; }
            return true;
        } else {
            if (!tile_of((long)i * G + c, nrt(), 4, pm, pn)) return false;
            pm = rowtile(pm);
            u.A = Z + (size_t)pm * 256 * (ZP * 2); u.lda2 = ZP * 2; u.B = W + W_OUT + (size_t)pn * 256 * 2048; u.nt = 16; u.kind = EP_OUT; u.pm = pm; u.pn = pn; u.aux = 0; return true;
        }
    }
};

struct GEpi {
    bf16_t* Z; bf16_t* KR; float* ssq_q; float* ssq_kv; bf16_t* Qb; bf16_t* KVb; unsigned char* gscr; const f32x2* tab;
    __device__ __forceinline__ void mid(f32x4 (&acc)[2][2][4][2], int which, int tid) const {
        unsigned t16 = (unsigned)tid * 16u; asm volatile("" : "+v"(t16));
#pragma unroll
        for (int ab = 0; ab < 4; ++ab) {
            u32x4 ga[4], gb[4];
#pragma unroll
            for (int m = 0; m < 4; ++m) { const unsigned char* sb = gscr + (size_t)((which * 16 + ab * 4 + m) * 8192);
                ga[m] = *(const u32x4*)(sb + t16); gb[m] = *(const u32x4*)(sb + 16 * 8192 + t16); }
            __builtin_amdgcn_sched_barrier(0);
#pragma unroll
            for (int m = 0; m < 4; ++m) { f32x4& a0 = acc[ab >> 1][ab & 1][m][0]; f32x4& a1 = acc[ab >> 1][ab & 1][m][1];
                a0[0] *= (1.f + bflo(gb[m].x)) * frcp(1.f + bflo(ga[m].x)); a0[1] *= (1.f + bfhi(gb[m].x)) * frcp(1.f + bfhi(ga[m].x));
                a0[2] *= (1.f + bflo(gb[m].y)) * frcp(1.f + bflo(ga[m].y)); a0[3] *= (1.f + bfhi(gb[m].y)) * frcp(1.f + bfhi(ga[m].y));
                a1[0] *= (1.f + bflo(gb[m].z)) * frcp(1.f + bflo(ga[m].z)); a1[1] *= (1.f + bfhi(gb[m].z)) * frcp(1.f + bfhi(ga[m].z));
                a1[2] *= (1.f + bflo(gb[m].w)) * frcp(1.f + bflo(ga[m].w)); a1[3] *= (1.f + bfhi(gb[m].w)) * frcp(1.f + bfhi(ga[m].w)); }
            __builtin_amdgcn_sched_barrier(0);
        }
    }
    __device__ __forceinline__ void operator()(f32x4 (&acc)[2][2][4][2], const GUnit& u, int wr, int wc, int fr, int fq, int tid) const {
        const int k = u.kind;
        if (k == EP_ZIN) run<EP_ZIN>(acc, u, wr, wc, fr, fq, tid); else if (k == EP_Q) run<EP_Q>(acc, u, wr, wc, fr, fq, tid); else if (k == EP_KV) run<EP_KV>(acc, u, wr, wc, fr, fq, tid);
        else if (k == EP_GATE) run<EP_GATE>(acc, u, wr, wc, fr, fq, tid); else if (k == EP_MERGE) run<EP_MERGE>(acc, u, wr, wc, fr, fq, tid); else run<EP_OUT>(acc, u, wr, wc, fr, fq, tid);
    }
    template <int KIND> __device__ __forceinline__ void run(f32x4 (&acc)[2][2][4][2], const GUnit& u, int wr, int wc, int fr, int fq, int tid) const {
        constexpr int kind = KIND; const int pn = u.pn;
        unsigned t16 = (unsigned)tid * 16u; asm volatile("" : "+v"(t16));
        u32x4 ggv[16];
        if (kind == EP_MERGE) {
#pragma unroll
            for (int i = 0; i < 16; ++i) ggv[i] = *(const u32x4*)(gscr + (size_t)((2 * 16 + i) * 8192) + t16);
        } else {
#pragma unroll
            for (int i = 0; i < 16; ++i) ggv[i] = (u32x4){0u, 0u, 0u, 0u}; }
        __builtin_amdgcn_sched_barrier(0);
#pragma unroll
        for (int ai = 0; ai < 2; ++ai)
#pragma unroll
            for (int m = 0; m < 4; ++m) {
                const int row = u.pm * 256 + ai * 128 + wr * 64 + m * 16 + fr;
                if (kind == EP_ZIN) {
                    const int act = (pn == 4) ? 1 : (pn >= 8 ? 2 : 0);
                    float ss0 = 0.f, ss1 = 0.f;
#pragma unroll
                    for (int bj = 0; bj < 2; ++bj) {
                        f32x4 v0 = acc[ai][bj][m][0], v1 = acc[ai][bj][m][1];
                        if (act == 1) { v0 *= 0.125f; v1 *= 0.125f; }
                        if (act == 2) {
#pragma unroll
                            for (int j = 0; j < 4; ++j) { v0[j] = siluf_(v0[j]); v1[j] = siluf_(v1[j]); } }
                        *(u32x4*)(Z + (size_t)row * ZP + pn * 256 + bj * 128 + wc * 32 + 8 * fq) = pack8(v0, v1);
                        if (pn <= 1) { float s = 0.f;
#pragma unroll
                            for (int j = 0; j < 4; ++j) s += v0[j] * v0[j] + v1[j] * v1[j];
                            if (bj == 0) ss0 = s; else ss1 = s; }
                    }
                    if (pn <= 1) {
                        float s = (pn == 0) ? (ss0 + ss1) : ss0;
                        s += __shfl_xor(s, 16); s += __shfl_xor(s, 32);
                        if (fq == 0) atomicAdd((pn == 0 ? ssq_q : ssq_kv) + row, s);
                        if (pn == 1 && wc < 2) {
                            const f32x4 mn = acc[ai][1][m][0], rt = acc[ai][1][m][1]; f32x4 o = mn;
                            const int tok = row % TOK;
                            if (tok >= CTXL) { const int t = tok - CTXL; const int pos = (wc == 0) ? (t >> 6) : (t & 63);
#pragma unroll
                                for (int j = 0; j < 4; ++j) { const float rv = (float)pos * (fexp2(-(float)(4 * (fq & 1) + j) * (13.287712379549449f / 8.f)) * 0.15915494309189535f);     const float fr_ = rv - floorf(rv); o[j] = mn[j] * __builtin_amdgcn_cosf(fr_) + rt[j] * __builtin_amdgcn_sinf(fr_); } }
                            u32x2 pk; pk.x = cvtpk(o[0], o[1]); pk.y = cvtpk(o[2], o[3]);
                            *(u32x2*)(KR + (size_t)row * 32 + 4 * (4 * wc + fq)) = pk;
                        }
                    }
                } else if (kind == EP_Q) {
                    const float rs = __builtin_amdgcn_rsqf(ssq_q[row] * (1.f / 256.f) + EPS) * QSCALE;
                    const int tok = row % TOK;
#pragma unroll
                    for (int bj = 0; bj < 2; ++bj) {
                        const int head = 2 * pn + bj;
                        f32x4 v0 = acc[ai][bj][m][0] * rs, v1 = acc[ai][bj][m][1] * rs;
                        if (wc < 2) { *(u32x4*)(Qb + (size_t)row * 768 + head * 96 + wc * 32 + 8 * fq) = pack8(v0, v1); }
                        else { f32x4 o = v0; const int g = 4 * (wc - 2) + fq;
                            if (tok >= CTXL) { const int t = tok - CTXL; const int pos = (wc == 2) ? (t >> 6) : (t & 63);
#pragma unroll
                                for (int j = 0; j < 4; ++j) { const float rv = (float)pos * (fexp2(-(float)(4 * (fq & 1) + j) * (13.287712379549449f / 8.f)) * 0.15915494309189535f);     const float fr_ = rv - floorf(rv); o[j] = v0[j] * __builtin_amdgcn_cosf(fr_) + v1[j] * __builtin_amdgcn_sinf(fr_); } }
                            u32x2 pk; pk.x = cvtpk(o[0], o[1]); pk.y = cvtpk(o[2], o[3]);
                            *(u32x2*)(Qb + (size_t)row * 768 + head * 96 + 64 + 4 * g) = pk; }
                    }
                } else if (kind == EP_KV) {
                    const float rs = __builtin_amdgcn_rsqf(ssq_kv[row] * (1.f / 128.f) + EPS);
#pragma unroll
                    for (int bj = 0; bj < 2; ++bj)
                        *(u32x4*)(KVb + (size_t)row * 1024 + pn * 256 + bj * 128 + wc * 32 + 8 * fq) = pack8(acc[ai][bj][m][0] * rs, acc[ai][bj][m][1] * rs);
                } else if (kind == EP_GATE) {
#pragma unroll
                    for (int bj = 0; bj < 2; ++bj) { f32x4 v0 = acc[ai][bj][m][0], v1 = acc[ai][bj][m][1];
#pragma unroll
                        for (int j = 0; j < 4; ++j) { v0[j] = fminf(fexp(-v0[j]), 1e18f); v1[j] = fminf(fexp(-v1[j]), 1e18f); }
                        *(u32x4*)(gscr + (size_t)((u.aux * 16 + (ai * 2 + bj) * 4 + m) * 8192) + t16) = pack8(v0, v1); }
                } else if (kind == EP_MERGE) {
#pragma unroll
                    for (int bj = 0; bj < 2; ++bj) {
                        const u32x4 gg = ggv[(ai * 2 + bj) * 4 + m];
                        f32x4 v0 = acc[ai][bj][m][0], v1 = acc[ai][bj][m][1];
                        v0[0] *= frcp(1.f + bflo(gg.x)); v0[1] *= frcp(1.f + bfhi(gg.x)); v0[2] *= frcp(1.f + bflo(gg.y)); v0[3] *= frcp(1.f + bfhi(gg.y));
                        v1[0] *= frcp(1.f + bflo(gg.z)); v1[1] *= frcp(1.f + bfhi(gg.z)); v1[2] *= frcp(1.f + bflo(gg.w)); v1[3] *= frcp(1.f + bfhi(gg.w));
                        *(u32x4*)(Z + (size_t)row * ZP + pn * 256 + bj * 128 + wc * 32 + 8 * fq) = pack8(v0, v1); }
                } else {
#pragma unroll
                    for (int bj = 0; bj < 2; ++bj)
                        *(u32x4*)(Z + (size_t)row * ZP + 1024 + pn * 256 + bj * 128 + wc * 32 + 8 * fq) = pack8(acc[ai][bj][m][0], acc[ai][bj][m][1]);
                }
                __builtin_amdgcn_sched_barrier(0);
            }
    }
};

__device__ __forceinline__ void gemm_phase(LAS unsigned char* lds, const GSched& S, const GEpi& E, bool dry) {
    int tid = threadIdx.x; asm volatile("" : "+v"(tid)); const int wid = __builtin_amdgcn_readfirstlane(tid >> 6), lane = tid & 63, wr = wid >> 2, wc = wid & 3, fr = lane & 15, fq = lane >> 4;
    int R0, C0; stage_rc(tid * 16, R0, C0);
    const int Rb0 = (R0 & ~31) + perm32(R0 & 31); const int C02 = C0 * 2;
    const unsigned ldsw = (unsigned)wid * 1024u;
    const int aoff = lds_byte(wr * 64 + fr, fq * 8), boff = lds_byte(wc * 32 + fr, fq * 8);
#define PG8_SA(b, h) (((b) * 2 + (h)) * HTB)
#define PG8_SB(b, h) ((4 + (b) * 2 + (h)) * HTB)
#define PG8_STAGE(bufoff, gbase, ld, rowv) do { const unsigned _v = (unsigned)((rowv) * (ld) + C02); \
        __builtin_amdgcn_global_load_lds((const unsigned*)((const char*)(gbase) + _v), (LAS unsigned*)(lds + (bufoff) + ldsw), 16, 0, 0); \
        __builtin_amdgcn_global_load_lds((const unsigned*)((const char*)(gbase) + (size_t)64 * (ld) + _v), (LAS unsigned*)(lds + (bufoff) + ldsw + 8192), 16, 0, 0); } while (0)
#define PG8_LDA(dst, b, h) do { _Pragma("unroll") for (int m = 0; m < 4; ++m) _Pragma("unroll") for (int k = 0; k < 2; ++k) dst[m][k] = *(const LAS bf16x8*)(lds + PG8_SA(b, h) + aoff + m * 2048 + k * 1024); } while (0)
#define PG8_LDB(dst, b, h) do { _Pragma("unroll") for (int n = 0; n < 2; ++n) _Pragma("unroll") for (int k = 0; k < 2; ++k) dst[n][k] = *(const LAS bf16x8*)(lds + PG8_SB(b, h) + boff + n * 2048 + k * 1024); } while (0)
#define PG8_MMA(ai, bj, At, Bt) do { __builtin_amdgcn_s_setprio(1); _Pragma("unroll") for (int m = 0; m < 4; ++m) _Pragma("unroll") for (int n = 0; n < 2; ++n) _Pragma("unroll") for (int k = 0; k < 2; ++k) \
        acc[ai][bj][m][n] = __builtin_amdgcn_mfma_f32_16x16x32_bf16(Bt[n][k], At[m][k], acc[ai][bj][m][n], 0, 0, 0); __builtin_amdgcn_s_setprio(0); } while (0)
#define PG8_WAIT_V(n) asm volatile("s_waitcnt vmcnt(" #n ")" ::: "memory")
#define PG8_WAIT_L(n) asm volatile("s_waitcnt lgkmcnt(" #n ")" ::: "memory")
#define PG8_BAR __builtin_amdgcn_s_barrier()
#define PG8_SCHED __builtin_amdgcn_sched_barrier(0)
    GUnit cur, nxt; int ui = 0;
    if (!S.next(0, cur)) return;
    f32x4 acc[2][2][4][2];
#pragma unroll
    for (int a = 0; a < 2; ++a)
#pragma unroll
        for (int b = 0; b < 2; ++b)
#pragma unroll
            for (int m = 0; m < 4; ++m)
#pragma unroll
                for (int n = 0; n < 2; ++n) acc[a][b][m][n] = (f32x4){0.f, 0.f, 0.f, 0.f};
    bf16x8 At[4][2], B0[2][2], B1[2][2];
    const char* cA = cur.A; const char* cB = cur.B;
    int ldA = cur.lda2, ldB = cur.nt * 128;
    const size_t kstep = 128;
    PG8_STAGE(PG8_SB(0, 0), cB, ldB, Rb0); PG8_STAGE(PG8_SB(0, 1), cB + (size_t)HALF * ldB, ldB, Rb0); PG8_STAGE(PG8_SA(0, 0), cA, ldA, R0); PG8_STAGE(PG8_SA(0, 1), cA + (size_t)HALF * ldA, ldA, R0);
    if (wr == 1) PG8_BAR;
    PG8_WAIT_V(2); PG8_BAR;
    PG8_STAGE(PG8_SB(1, 0), cB + kstep, ldB, Rb0); PG8_STAGE(PG8_SA(1, 0), cA + kstep, ldA, R0); PG8_STAGE(PG8_SB(1, 1), cB + (size_t)HALF * ldB + kstep, ldB, Rb0);
    PG8_WAIT_V(6); PG8_BAR;
    for (;;) {
        const bool has_next = S.next(ui + 1, nxt);
        const char* nA = has_next ? nxt.A : cA; const char* nB = has_next ? nxt.B : cB;
        const int nldA = has_next ? nxt.lda2 : ldA, nldB = has_next ? nxt.nt * 128 : ldB;
        const int nt = cur.nt;
        for (int t = 0; t < nt; t += 2) {
            const bool last = (t == nt - 2);
            if (cur.kind == EP_MERGE && (t == 8 || t == 16)) E.mid(acc, t == 8 ? 0 : 1, tid);
            const char* a1 = cA + (size_t)(t + 1) * kstep;
            const char* a2 = last ? nA : cA + (size_t)(t + 2) * kstep; const char* b2 = last ? nB : cB + (size_t)(t + 2) * kstep;
            const char* a3 = a2 + kstep; const char* b3 = b2 + kstep;
            const int xldA = last ? nldA : ldA, xldB = last ? nldB : ldB;
            PG8_LDB(B0, 0, 0); PG8_LDB(B1, 0, 1); PG8_SCHED; PG8_LDA(At, 0, 0); PG8_STAGE(PG8_SA(1, 1), a1 + (size_t)HALF * ldA, ldA, R0);
            PG8_WAIT_V(8); PG8_WAIT_L(0); PG8_BAR; PG8_MMA(0, 0, At, B0); PG8_MMA(0, 1, At, B1); PG8_BAR; PG8_SCHED;
            PG8_LDA(At, 0, 1); PG8_STAGE(PG8_SB(0, 0), b2, xldB, Rb0); PG8_STAGE(PG8_SB(0, 1), b2 + (size_t)HALF * xldB, xldB, Rb0); PG8_STAGE(PG8_SA(0, 0), a2, xldA, R0);
            PG8_WAIT_V(8); PG8_WAIT_L(0); PG8_BAR; PG8_MMA(1, 0, At, B0); PG8_MMA(1, 1, At, B1); PG8_BAR; PG8_SCHED;
            PG8_LDB(B0, 1, 0); PG8_LDB(B1, 1, 1); PG8_SCHED; PG8_LDA(At, 1, 0); PG8_STAGE(PG8_SA(0, 1), a2 + (size_t)HALF * xldA, xldA, R0);
            PG8_WAIT_V(8); PG8_WAIT_L(0); PG8_BAR; PG8_MMA(0, 0, At, B0); PG8_MMA(0, 1, At, B1); PG8_BAR; PG8_SCHED;
            PG8_LDA(At, 1, 1); PG8_STAGE(PG8_SB(1, 0), b3, xldB, Rb0); PG8_STAGE(PG8_SB(1, 1), b3 + (size_t)HALF * xldB, xldB, Rb0); PG8_STAGE(PG8_SA(1, 0), a3, xldA, R0);
            PG8_WAIT_V(8); PG8_WAIT_L(0); PG8_BAR; PG8_MMA(1, 0, At, B0); PG8_MMA(1, 1, At, B1); PG8_BAR; PG8_SCHED;
        }
        if (wr == 0) PG8_BAR;
        if (!dry) E(acc, cur, wr, wc, fr, fq, tid);
        if (!has_next) break;
#pragma unroll
        for (int a = 0; a < 2; ++a)
#pragma unroll
            for (int b = 0; b < 2; ++b)
#pragma unroll
                for (int m = 0; m < 4; ++m)
#pragma unroll
                    for (int n = 0; n < 2; ++n) acc[a][b][m][n] = (f32x4){0.f, 0.f, 0.f, 0.f};
        cur = nxt; cA = nA; cB = nB; ldA = nldA; ldB = nldB; ++ui;
        if (wr == 1) PG8_BAR;
    }
    PG8_WAIT_V(0);
    PG8_BAR;
}

constexpr int AK_PITCH = 208, AK_BYTES = 64 * AK_PITCH, AV_BYTES = 8192;
constexpr int A_K0 = 0, A_V0 = 4 * AK_BYTES, A_WS = A_V0 + 4 * AV_BYTES, A_OST = A_WS + 2048, A_OP = 144, A_END = A_OST + 8 * 32 * A_OP;
static_assert(A_END <= 147200, "attention lds");
__device__ __forceinline__ float max3f(float a, float b, float c) { return fmaxf(fmaxf(a, b), c); }
__device__ __forceinline__ void attn_unit(LAS char* lds, const bf16_t* Qp, const bf16_t* KVp, const bf16_t* KRp, int ntiles, bf16_t* Yp, bool dry) {
    int tid = threadIdx.x; asm volatile("" : "+v"(tid)); const int lane = tid & 63, r32 = lane & 31, hi = lane >> 5; const int wid = __builtin_amdgcn_readfirstlane(tid >> 6);
    LAS float* wsf = (LAS float*)(lds + A_WS) + wid * 64;
    const int krow = tid >> 3, kc = tid & 7, rrow = tid >> 2, rc = tid & 3;
    const bf16_t* gk = KVp + (size_t)krow * 1024 + kc * 8;
    const bf16_t* gv = gk + 512;
    const bf16_t* gr = KRp + (size_t)rrow * 32 + rc * 8;
    const int lk = krow * AK_PITCH + kc * 16, lr = rrow * AK_PITCH + 128 + rc * 16, lv = (kc >> 2) * 4096 + krow * 64 + (kc & 3) * 16;
    const bool rth = tid < 256;
    u32x4 skA, svA, srA = {0u, 0u, 0u, 0u}, skB, svB, srB = {0u, 0u, 0u, 0u};
#define AT_LOAD(X, t) do { const size_t adv_ = (size_t)(t) * 64; sk##X = *(const u32x4*)(gk + adv_ * 1024); sv##X = *(const u32x4*)(gv + adv_ * 1024); if (rth) sr##X = *(const u32x4*)(gr + adv_ * 32); } while (0)
#define AT_STORE(X, slot) do { *(LAS u32x4*)(lds + A_K0 + (slot) * AK_BYTES + lk) = sk##X; *(LAS u32x4*)(lds + A_V0 + (slot) * AV_BYTES + lv) = sv##X; if (rth) *(LAS u32x4*)(lds + A_K0 + (slot) * AK_BYTES + lr) = sr##X; } while (0)
    AT_LOAD(A, 0); AT_LOAD(B, 1);
    bf16x8 qf[6];
    { const bf16_t* qrow = Qp + (size_t)(wid * 32 + r32) * 768;
#pragma unroll
      for (int s = 0; s < 6; ++s) qf[s] = *(const bf16x8*)(qrow + 16 * s + 8 * hi); }
    AT_STORE(A, 0); AT_STORE(B, 1);
    __syncthreads();
    float mref = 0.f, lsum = 0.f;
    f32x16 o0 = {}, o1 = {};
    const int g16 = (lane >> 4) & 1, q4 = (lane & 15) >> 2, p4 = lane & 3;
    const int vtr = (4 * hi + q4) * 64 + (16 * g16 + 4 * p4) * 2;
#define AT_QK(slot, P0, P1) do { const LAS char* Kb = lds + A_K0 + (slot) * AK_BYTES; \
        _Pragma("unroll") for (int s = 0; s < 6; ++s) { \
            const bf16x8 k0 = *(const LAS bf16x8*)(Kb + r32 * AK_PITCH + (16 * s + 8 * hi) * 2); \
            const bf16x8 k1 = *(const LAS bf16x8*)(Kb + (r32 + 32) * AK_PITCH + (16 * s + 8 * hi) * 2); \
            P0 = __builtin_amdgcn_mfma_f32_32x32x16_bf16(k0, qf[s], P0, 0, 0, 0); P1 = __builtin_amdgcn_mfma_f32_32x32x16_bf16(k1, qf[s], P1, 0, 0, 0); } } while (0)
#define AT_SMPV(slot, first, p0, p1) do { const LAS char* Vb = lds + A_V0 + (slot) * AV_BYTES; \
        float ra = max3f(p0[0], p0[1], p1[0]), rb = max3f(p0[2], p0[3], p1[1]); ra = max3f(ra, p1[2], p1[3]); \
        _Pragma("unroll") for (int r = 4; r < 16; r += 4) { ra = max3f(ra, p0[r], p0[r + 1]); rb = max3f(rb, p0[r + 2], p0[r + 3]); ra = max3f(ra, p1[r], p1[r + 1]); rb = max3f(rb, p1[r + 2], p1[r + 3]); } \
        float rm = fmaxf(ra, rb); rm = fmaxf(rm, __shfl_xor(rm, 32)) - mref; \
        if ((first) || __any(rm > 8.f)) { \
            const float dl = (first) ? rm : fmaxf(rm, 0.f); mref += dl; const float al = fexp2(-dl); lsum *= al; \
            if (!(first)) { if (hi == 0) wsf[r32] = al; \
                asm volatile("s_waitcnt lgkmcnt(0)" ::: "memory"); \
                _Pragma("unroll") for (int k = 0; k < 4; ++k) { const f32x4 a = *(const LAS f32x4*)(wsf + 8 * k + 4 * hi); \
                    _Pragma("unroll") for (int j = 0; j < 4; ++j) { o0[4 * k + j] *= a[j]; o1[4 * k + j] *= a[j]; } } } \
        } \
        _Pragma("unroll") for (int r = 0; r < 16; ++r) { p0[r] = fexp2(p0[r] - mref); p1[r] = fexp2(p1[r] - mref); } \
        { float sa = p0[0] + p1[0], sb = p0[1] + p1[1], sc_ = p0[2] + p1[2], sd = p0[3] + p1[3]; \
          _Pragma("unroll") for (int r = 4; r < 16; r += 4) { sa += p0[r] + p1[r]; sb += p0[r + 1] + p1[r + 1]; sc_ += p0[r + 2] + p1[r + 2]; sd += p0[r + 3] + p1[r + 3]; } \
          lsum += (sa + sb) + (sc_ + sd); } \
        u32x4 pw[4]; \
        pw[0] = (u32x4){cvtpk(p0[0], p0[1]), cvtpk(p0[2], p0[3]), cvtpk(p0[4], p0[5]), cvtpk(p0[6], p0[7])}; \
        pw[1] = (u32x4){cvtpk(p0[8], p0[9]), cvtpk(p0[10], p0[11]), cvtpk(p0[12], p0[13]), cvtpk(p0[14], p0[15])}; \
        pw[2] = (u32x4){cvtpk(p1[0], p1[1]), cvtpk(p1[2], p1[3]), cvtpk(p1[4], p1[5]), cvtpk(p1[6], p1[7])}; \
        pw[3] = (u32x4){cvtpk(p1[8], p1[9]), cvtpk(p1[10], p1[11]), cvtpk(p1[12], p1[13]), cvtpk(p1[14], p1[15])}; \
        _Pragma("unroll") for (int u = 0; u < 4; ++u) { \
            const LAS char* vb = Vb + vtr + u * 16 * 64; \
            const s16x4 a0 = trread(vb), a1 = trread(vb + 8 * 64), b0 = trread(vb + 4096), b1 = trread(vb + 4096 + 8 * 64); \
            o0 = __builtin_amdgcn_mfma_f32_32x32x16_bf16(__builtin_bit_cast(bf16x8, pw[u]), MK8(a0, a1), o0, 0, 0, 0); \
            o1 = __builtin_amdgcn_mfma_f32_32x32x16_bf16(__builtin_bit_cast(bf16x8, pw[u]), MK8(b0, b1), o1, 0, 0, 0); } \
    } while (0)
    for (int t = 0; t < ntiles; t += 2) {
        const int sb0 = (t & 2);
        const bool more = (t + 2 < ntiles);
        f32x16 pa0 = {}, pa1 = {}, pb0 = {}, pb1 = {};
        AT_QK(sb0, pa0, pa1);
        AT_QK(sb0 + 1, pb0, pb1);
        if (t == 0) AT_SMPV(sb0, true, pa0, pa1); else AT_SMPV(sb0, false, pa0, pa1);
        __builtin_amdgcn_sched_barrier(0);
        if (more) { AT_LOAD(A, t + 2); AT_LOAD(B, t + 3); }
        AT_SMPV(sb0 + 1, false, pb0, pb1);
        if (more) { AT_STORE(A, sb0 ^ 2); AT_STORE(B, (sb0 ^ 2) + 1); }
        __syncthreads();
    }
#undef AT_LOAD
#undef AT_STORE
#undef AT_QK
#undef AT_SMPV
    lsum += __shfl_xor(lsum, 32);
    if (hi == 0) wsf[r32] = frcp(lsum);
    asm volatile("s_waitcnt lgkmcnt(0)" ::: "memory");
    LAS char* ost = lds + A_OST + wid * (32 * A_OP);
#pragma unroll
    for (int k = 0; k < 4; ++k) { const f32x4 a = *(const LAS f32x4*)(wsf + 8 * k + 4 * hi);
#pragma unroll
        for (int j = 0; j < 4; ++j) { const int r = 4 * k + j; LAS bf16_t* op = (LAS bf16_t*)(ost + crow(r, hi) * A_OP) + r32;
            op[0] = f2bf(o0[r] * a[j]); op[32] = f2bf(o1[r] * a[j]); } }
    asm volatile("s_waitcnt lgkmcnt(0)" ::: "memory");
#pragma unroll
    for (int i = 0; i < 4; ++i) { const int id = lane + 64 * i, row = id >> 3, ch = id & 7;
        const u32x4 ov = *(const LAS u32x4*)(ost + row * A_OP + ch * 16);
        bf16_t* yp = Yp + (size_t)(wid * 32 + row) * ZP + ch * 8;
        if (!dry) { const u32x4 gv = *(const u32x4*)yp; u32x4 w;
            w.x = cvtpk(bflo(ov.x) * bflo(gv.x), bfhi(ov.x) * bfhi(gv.x)); w.y = cvtpk(bflo(ov.y) * bflo(gv.y), bfhi(ov.y) * bfhi(gv.y));
            w.z = cvtpk(bflo(ov.z) * bflo(gv.z), bfhi(ov.z) * bfhi(gv.z)); w.w = cvtpk(bflo(ov.w) * bflo(gv.w), bfhi(ov.w) * bfhi(gv.w));
            *(u32x4*)yp = w; } }
    __syncthreads();
}

constexpr int GP = 144, GARR = 64 * GP;
constexpr int G_Q = 0, G_K = GARR, G_KD = 2 * GARR, G_V = 3 * GARR, G_AM = 4 * GARR, G_SB = 5 * GARR, G_O = 6 * GARR, G_A16 = 7 * GARR, G_DEC = G_A16 + 2048, G_TOT = G_DEC + 256, G_GROUP = 68096;
static_assert(G_TOT + 512 <= G_GROUP && 2 * G_GROUP <= 147200, "gla lds");
__device__ __forceinline__ void gla_unit(LAS char* lds0, int b, int h, int dvh, bf16_t* Z, bf16_t* OT, const float* afw, const float* afb, const float* abw, const float* abb, bool dry) {
    int tid = threadIdx.x; asm volatile("" : "+v"(tid)); const int lane = tid & 63, r32 = lane & 31, hi = lane >> 5; const int wid = __builtin_amdgcn_readfirstlane(tid >> 6);
    const int dir = wid >> 2, wg = wid & 3, tg = tid & 255;
    LAS char* lds = lds0 + dir * G_GROUP;
    const int g16 = (lane >> 4) & 1, q4 = (lane & 15) >> 2, p4 = lane & 3;
    const int I = wg >> 1, J = wg & 1;
    const float* w2 = dir ? abw : afw; const float* bb = dir ? abb : afb;
    bf16x8 w2b;
    { u32x4 t; t.x = cvtpk(w2[(8 * hi + 0) * 256 + h * 64 + 32 * J + r32], w2[(8 * hi + 1) * 256 + h * 64 + 32 * J + r32]);
      t.y = cvtpk(w2[(8 * hi + 2) * 256 + h * 64 + 32 * J + r32], w2[(8 * hi + 3) * 256 + h * 64 + 32 * J + r32]);
      t.z = cvtpk(w2[(8 * hi + 4) * 256 + h * 64 + 32 * J + r32], w2[(8 * hi + 5) * 256 + h * 64 + 32 * J + r32]);
      t.w = cvtpk(w2[(8 * hi + 6) * 256 + h * 64 + 32 * J + r32], w2[(8 * hi + 7) * 256 + h * 64 + 32 * J + r32]);
      w2b = __builtin_bit_cast(bf16x8, t); }
    const float bias = bb[h * 64 + 32 * J + r32];
    const int zcol_a = dir ? ZAB : ZAF;
    f32x16 S = {};
    for (int i = tg; i < GARR / 4; i += 256) ((LAS unsigned*)(lds + G_SB))[i] = 0u;
    u32x4 pq0, pq1, pk0, pk1, pv0, pv1; u32x2 pa;
    const int lr = tg >> 3, lc = tg & 7, ar = tg >> 2, ac = tg & 3;
#define GLA_CHUNK(s) (dir ? ((s) < 4 ? 3 - (s) : 39 - (s)) : (s))
#define GLA_ROW(rb, i) ((rb) + (dir ? 63 - (i) : (i)))
#define GLA_PREFETCH(s) do { const size_t rb_ = (size_t)b * TOK + 64 * GLA_CHUNK(s); \
        const bf16_t* z0_ = Z + GLA_ROW(rb_, lr) * ZP; const bf16_t* z1_ = Z + GLA_ROW(rb_, lr + 32) * ZP; \
        pq0 = *(const u32x4*)(z0_ + ZGQ + h * 64 + lc * 8); pq1 = *(const u32x4*)(z1_ + ZGQ + h * 64 + lc * 8); \
        pk0 = *(const u32x4*)(z0_ + ZGK + h * 64 + lc * 8); pk1 = *(const u32x4*)(z1_ + ZGK + h * 64 + lc * 8); \
        pv0 = *(const u32x4*)(z0_ + ZGV + h * 128 + dvh * 64 + lc * 8); pv1 = *(const u32x4*)(z1_ + ZGV + h * 128 + dvh * 64 + lc * 8); \
        pa = *(const u32x2*)(Z + GLA_ROW(rb_, ar) * ZP + zcol_a + ac * 4); } while (0)
    GLA_PREFETCH(0);
    for (int s = 0; s < 36; ++s) {
        const int c = GLA_CHUNK(s);
        const size_t rbase = (size_t)b * TOK + 64 * c;
        const int other_step = dir ? c : (c < 4 ? 3 - c : 39 - c);
        const bool second = s > other_step;
        *(LAS u32x4*)(lds + G_Q + lr * GP + lc * 16) = pq0; *(LAS u32x4*)(lds + G_Q + (lr + 32) * GP + lc * 16) = pq1;
        *(LAS u32x4*)(lds + G_K + lr * GP + lc * 16) = pk0; *(LAS u32x4*)(lds + G_K + (lr + 32) * GP + lc * 16) = pk1;
        *(LAS u32x4*)(lds + G_V + lr * GP + lc * 16) = pv0; *(LAS u32x4*)(lds + G_V + (lr + 32) * GP + lc * 16) = pv1;
        *(LAS u32x2*)(lds + G_A16 + ar * 32 + ac * 8) = pa;
        __syncthreads();
        if (s + 1 < 36) GLA_PREFETCH(s + 1);
        u32x4 prv0 = {0u, 0u, 0u, 0u}, prv1 = {0u, 0u, 0u, 0u};
        bf16_t* og0 = OT + GLA_ROW(rbase, lr) * 512 + h * 128 + dvh * 64 + lc * 8;
        bf16_t* og1 = OT + GLA_ROW(rbase, lr + 32) * 512 + h * 128 + dvh * 64 + lc * 8;
        if (second) { prv0 = *(const u32x4*)og0; prv1 = *(const u32x4*)og1; }
        float cs[16];
        {
            f32x16 zc;
#pragma unroll
            for (int r = 0; r < 16; ++r) zc[r] = bias;
            const bf16x8 a = *(const LAS bf16x8*)(lds + G_A16 + (32 * I + r32) * 32 + hi * 16);
            zc = __builtin_amdgcn_mfma_f32_32x32x16_bf16(a, w2b, zc, 0, 0, 0);
#pragma unroll
            for (int r = 0; r < 16; ++r) { const float z = zc[r]; cs[r] = (fminf(z, 0.f) - __logf(1.f + fexp(-fabsf(z)))) * (1.f / 16.f); }
        }
#pragma unroll
        for (int g = 0; g < 4; ++g) { cs[4 * g + 1] += cs[4 * g]; cs[4 * g + 2] += cs[4 * g + 1]; cs[4 * g + 3] += cs[4 * g + 2]; }
        float run = 0.f;
#pragma unroll
        for (int g = 0; g < 4; ++g) {
            const float mine = cs[4 * g + 3]; const float oth = __shfl_xor(mine, 32);
            const float off = run + (hi ? oth : 0.f);
#pragma unroll
            for (int j = 0; j < 4; ++j) cs[4 * g + j] += off;
            run += mine + oth;
        }
        if (hi == 0) ((LAS float*)(lds + G_TOT))[I * 64 + 32 * J + r32] = run;
        asm volatile("s_waitcnt lgkmcnt(0)\n\ts_barrier" ::: "memory");
        const float t0v = ((LAS float*)(lds + G_TOT))[32 * J + r32], t1v = ((LAS float*)(lds + G_TOT))[64 + 32 * J + r32];
        const float pre = I ? t0v : 0.f, tot = t0v + t1v;
        const float etot = fexp(tot);
#pragma unroll
        for (int r = 0; r < 16; ++r) {
            const int ii = 32 * I + crow(r, hi), dd = 32 * J + r32; const float eb = fexp(pre + cs[r]); const float ieb = frcp(eb);
            LAS bf16_t* qp = (LAS bf16_t*)(lds + G_Q) + ii * (GP / 2) + dd; LAS bf16_t* kp = (LAS bf16_t*)(lds + G_K) + ii * (GP / 2) + dd;
            const float qv = bf2f(*qp), kv = bf2f(*kp);
            *qp = f2bf(qv * eb); *kp = f2bf(kv * ieb);
            ((LAS bf16_t*)(lds + G_KD))[ii * (GP / 2) + dd] = f2bf(kv * ieb * etot);
        }
        if (I == 0 && hi == 0) ((LAS float*)(lds + G_DEC))[32 * J + r32] = etot;
        asm volatile("s_waitcnt lgkmcnt(0)\n\ts_barrier" ::: "memory");
        f32x16 oacc = {};
        {
            f32x16 Ac = {};
            if (J <= I) {
#pragma unroll
                for (int k = 0; k < 4; ++k) {
                    const bf16x8 a = *(const LAS bf16x8*)(lds + G_Q + (32 * I + r32) * GP + (16 * k + 8 * hi) * 2);
                    const bf16x8 bq = *(const LAS bf16x8*)(lds + G_K + (32 * J + r32) * GP + (16 * k + 8 * hi) * 2);
                    Ac = __builtin_amdgcn_mfma_f32_32x32x16_bf16(a, bq, Ac, 0, 0, 0);
                }
            }
#pragma unroll
            for (int k = 0; k < 4; ++k) {
                const bf16x8 a = *(const LAS bf16x8*)(lds + G_Q + (32 * I + r32) * GP + (16 * k + 8 * hi) * 2);
                const LAS char* sp = lds + G_SB + (16 * k + 8 * hi + q4) * GP + (32 * J + 16 * g16 + 4 * p4) * 2;
                const s16x4 l0 = trread(sp), l1 = trread(sp + 4 * GP);
                oacc = __builtin_amdgcn_mfma_f32_32x32x16_bf16(a, MK8(l0, l1), oacc, 0, 0, 0);
            }
#pragma unroll
            for (int r = 0; r < 16; ++r) { const int i_ = 32 * I + crow(r, hi), j_ = 32 * J + r32;
                ((LAS bf16_t*)(lds + G_AM))[i_ * (GP / 2) + j_] = f2bf((i_ >= j_) ? Ac[r] : 0.f); }
        }
        asm volatile("s_waitcnt lgkmcnt(0)\n\ts_barrier" ::: "memory");
        {
#pragma unroll
            for (int u = 0; u < 4; ++u) {
                const bf16x8 a = *(const LAS bf16x8*)(lds + G_AM + (32 * I + r32) * GP + (16 * u + 8 * hi) * 2);
                const LAS char* vp = lds + G_V + (16 * u + 8 * hi + q4) * GP + (32 * J + 16 * g16 + 4 * p4) * 2;
                const s16x4 l0 = trread(vp), l1 = trread(vp + 4 * GP);
                oacc = __builtin_amdgcn_mfma_f32_32x32x16_bf16(a, MK8(l0, l1), oacc, 0, 0, 0);
            }
#pragma unroll
            for (int r = 0; r < 16; ++r) ((LAS bf16_t*)(lds + G_O))[(32 * I + crow(r, hi)) * (GP / 2) + 32 * J + r32] = f2bf(oacc[r]);
            const int Dd = I;
#pragma unroll
            for (int k = 0; k < 4; ++k) { const f32x4 dc = *(const LAS f32x4*)(lds + G_DEC + (32 * Dd + 8 * k + 4 * hi) * 4);
#pragma unroll
                for (int j = 0; j < 4; ++j) S[4 * k + j] *= dc[j]; }
#pragma unroll
            for (int u = 0; u < 4; ++u) {
                const LAS char* kp = lds + G_KD + (16 * u + 8 * hi + q4) * GP + (32 * Dd + 16 * g16 + 4 * p4) * 2;
                const LAS char* vp = lds + G_V + (16 * u + 8 * hi + q4) * GP + (32 * J + 16 * g16 + 4 * p4) * 2;
                const s16x4 k0 = trread(kp), k1 = trread(kp + 4 * GP), v0 = trread(vp), v1 = trread(vp + 4 * GP);
                S = __builtin_amdgcn_mfma_f32_32x32x16_bf16(MK8(k0, k1), MK8(v0, v1), S, 0, 0, 0);
            }
        }
        asm volatile("s_waitcnt lgkmcnt(0)\n\ts_barrier" ::: "memory");
#pragma unroll
        for (int r = 0; r < 16; ++r) ((LAS bf16_t*)(lds + G_SB))[(32 * I + crow(r, hi)) * (GP / 2) + 32 * J + r32] = f2bf(S[r]);
        {
            u32x4 o0v = *(const LAS u32x4*)(lds + G_O + lr * GP + lc * 16), o1v = *(const LAS u32x4*)(lds + G_O + (lr + 32) * GP + lc * 16);
            if (second) {
                o0v.x = cvtpk(bflo(o0v.x) + bflo(prv0.x), bfhi(o0v.x) + bfhi(prv0.x)); o0v.y = cvtpk(bflo(o0v.y) + bflo(prv0.y), bfhi(o0v.y) + bfhi(prv0.y));
                o0v.z = cvtpk(bflo(o0v.z) + bflo(prv0.z), bfhi(o0v.z) + bfhi(prv0.z)); o0v.w = cvtpk(bflo(o0v.w) + bflo(prv0.w), bfhi(o0v.w) + bfhi(prv0.w));
                o1v.x = cvtpk(bflo(o1v.x) + bflo(prv1.x), bfhi(o1v.x) + bfhi(prv1.x)); o1v.y = cvtpk(bflo(o1v.y) + bflo(prv1.y), bfhi(o1v.y) + bfhi(prv1.y));
                o1v.z = cvtpk(bflo(o1v.z) + bflo(prv1.z), bfhi(o1v.z) + bfhi(prv1.z)); o1v.w = cvtpk(bflo(o1v.w) + bflo(prv1.w), bfhi(o1v.w) + bfhi(prv1.w));
            }
            if (!dry) { *(u32x4*)og0 = o0v; *(u32x4*)og1 = o1v; }
        }
    }
    __syncthreads();
#undef GLA_CHUNK
#undef GLA_ROW
#undef GLA_PREFETCH
}

constexpr int PP = 272;
__device__ __forceinline__ void pool_unit(LAS char* lds, int pm, int g, bf16_t* Z, const bf16_t* Wt  , const float* pscale, bool dry) {
    int tid = threadIdx.x; asm volatile("" : "+v"(tid)); const int lane = tid & 63, r32 = lane & 31, hi = lane >> 5; const int wid = __builtin_amdgcn_readfirstlane(tid >> 6);
    const int col = tid & 127, rq = tid >> 7;
    const int half = 1 << g;
    const int tiw = pm % 9; const int L = (tiw == 0) ? CTXL : SEQ; const int t0 = (tiw == 0) ? 0 : (tiw - 1) * 256;
    const bf16_t* ub = Z + (size_t)(pm * 256 - t0) * ZP + ZPX + g * 128;
    LAS char* U = lds + 256 * PP;
    {
        u32x4 uv[9];
#pragma unroll
        for (int k = 0; k < 9; ++k) { const int i = tid + 512 * k; const int j = i >> 4, ch = i & 15; const int t = t0 - 8 + j;
            uv[k] = (u32x4){0u, 0u, 0u, 0u}; if (i < 272 * 16 && t >= 0 && t < L) uv[k] = *(const u32x4*)(ub + (size_t)t * ZP + ch * 8); }
#pragma unroll
        for (int k = 0; k < 9; ++k) { const int i = tid + 512 * k; const int j = i >> 4, ch = i & 15;
            if (i < 272 * 16) *(LAS u32x4*)(U + j * PP + ch * 16) = uv[k]; }
    }
    __syncthreads();
    {
        const LAS bf16_t* uc = (const LAS bf16_t*)U + col;
        const int ts = t0 + rq * 64;
        int lo = ts - half; if (lo < 0) lo = 0; int hiw = ts + half; if (hiw > L) hiw = L;
        float s = 0.f;
        for (int t = lo; t < hiw; ++t) s += bf2f(uc[(t - t0 + 8) * (PP / 2)]);
#pragma unroll 8
        for (int i = 0; i < 64; ++i) {
            const int t = ts + i;
            int l2 = t - half; if (l2 < 0) l2 = 0; int h2 = t + half; if (h2 > L) h2 = L;
            const float ut = bf2f(uc[(t - t0 + 8) * (PP / 2)]);
            const float pv = s * frcp((float)(h2 - l2)) - ut;
            ((LAS bf16_t*)lds)[(rq * 64 + i) * (PP / 2) + col] = f2bf(pv);
            if (t + half < L) s += bf2f(uc[(t + half - t0 + 8) * (PP / 2)]);
            if (t - half >= 0) s -= bf2f(uc[(t - half - t0 + 8) * (PP / 2)]);
        }
    }
    __syncthreads();
    f32x16 acc[4] = {};
#pragma unroll
    for (int s = 0; s < 8; ++s) {
        const bf16x8 a = *(const LAS bf16x8*)(lds + (32 * wid + r32) * PP + (16 * s + 8 * hi) * 2);
#pragma unroll
        for (int n = 0; n < 4; ++n) {
            const bf16x8 bw = *(const bf16x8*)(Wt + (size_t)(32 * n + r32) * 128 + 16 * s + 8 * hi);
            acc[n] = __builtin_amdgcn_mfma_f32_32x32x16_bf16(a, bw, acc[n], 0, 0, 0);
        }
    }
#pragma unroll
    for (int n = 0; n < 4; ++n) { const float sc = pscale[g * 128 + 32 * n + r32];
#pragma unroll
        for (int r = 0; r < 16; ++r) ((LAS bf16_t*)lds)[(32 * wid + crow(r, hi)) * (PP / 2) + 32 * n + r32] = f2bf(acc[n][r] * sc); }
    asm volatile("s_waitcnt lgkmcnt(0)" ::: "memory");
#pragma unroll
    for (int i = 0; i < 8; ++i) { const int id = lane + 64 * i, row = id >> 4, ch = id & 15;
        const u32x4 ov = *(const LAS u32x4*)(lds + (32 * wid + row) * PP + ch * 16);
        bf16_t* yp = Z + (size_t)(pm * 256 + 32 * wid + row) * ZP + ZYP + g * 128 + ch * 8;
        if (!dry) { const u32x4 gv = *(const u32x4*)yp; u32x4 w;
            w.x = cvtpk(bflo(ov.x) * bflo(gv.x), bfhi(ov.x) * bfhi(gv.x)); w.y = cvtpk(bflo(ov.y) * bflo(gv.y), bfhi(ov.y) * bfhi(gv.y));
            w.z = cvtpk(bflo(ov.z) * bflo(gv.z), bfhi(ov.z) * bfhi(gv.z)); w.w = cvtpk(bflo(ov.w) * bflo(gv.w), bfhi(ov.w) * bfhi(gv.w));
            *(u32x4*)yp = w; } }
    __syncthreads();
}

__device__ __forceinline__ void prep_item(const Params& p, int l, int mat, int n, int kc, unsigned char* wl) {
    const int k0 = kc * 8; float v[8];
    bf16_t* dst;
    if (mat == 0) {
        dst = (bf16_t*)(wl + W_IN) + (size_t)n * 1024 + k0;
        int col = -1; float sg = 1.f;
        if (n < 256) col = C_MQ + n;
        else if (n < 512) { const int cc = n - 256;
            if (cc < 128) col = C_MKV + cc;
            else if (cc < 192) { const int c2 = cc - 128, g = c2 >> 3, nn = (c2 >> 2) & 1, j = c2 & 3, i = 4 * g + j;
                if (nn == 0) col = C_MKR + i; else { const int i16 = i & 15, base = i & 16; if (i16 < 8) { col = C_MKR + base + i16 + 8; sg = -1.f; } else col = C_MKR + base + i16 - 8; } }
            else if (cc < 208) col = C_AF + cc - 192;
            else if (cc < 224) col = C_AB + cc - 208; }
        else if (n < 1024) col = C_PX + n - 512;
        else if (n < 1280) col = C_GQ + n - 1024;
        else if (n < 1536) col = C_GK + n - 1280;
        else if (n < 2048) col = C_GV + n - 1536;
        else if (n < 2560) col = C_MG + n - 2048;
        else if (n < 3072) col = C_PG + n - 2560;
        else col = C_GG + n - 3072;
        const float* src = p.w_in + (size_t)l * D * DIN;
#pragma unroll
        for (int i = 0; i < 8; ++i) v[i] = (col >= 0) ? sg * src[(size_t)(k0 + i) * DIN + col] : 0.f;
    } else if (mat == 1) {
        dst = (bf16_t*)(wl + W_M) + (size_t)n * 1024 + k0;
        const float* src = p.w_in + (size_t)l * D * DIN + C_MRG + n;
#pragma unroll
        for (int i = 0; i < 8; ++i) v[i] = src[(size_t)(k0 + i) * DIN];
    } else if (mat == 2) {
        dst = (bf16_t*)(wl + W_UQ) + (size_t)n * 256 + k0;
        const int head = n >> 7, cc = n & 127; int col; float sg = 1.f;
        if (cc < 64) col = head * 96 + cc;
        else { const int c2 = cc - 64, g = c2 >> 3, nn = (c2 >> 2) & 1, j = c2 & 3, i = 4 * g + j;
            if (nn == 0) col = head * 96 + 64 + i; else { const int i16 = i & 15, base = i & 16; if (i16 < 8) { col = head * 96 + 64 + base + i16 + 8; sg = -1.f; } else col = head * 96 + 64 + base + i16 - 8; } }
        const float* src = p.mla_w_uq + (size_t)l * 256 * 768 + col; const float* gn = p.mla_q_norm + l * 256;
#pragma unroll
        for (int i = 0; i < 8; ++i) v[i] = sg * gn[k0 + i] * src[(size_t)(k0 + i) * 768];
    } else if (mat == 3) {
        dst = (bf16_t*)(wl + W_UKV) + (size_t)n * 256 + k0;
        const int col = (n < 512) ? ((n >> 6) * 128 + (n & 63)) : (((n - 512) >> 6) * 128 + 64 + (n & 63));
        const float* src = p.mla_w_ukv + (size_t)l * 128 * 1024 + col; const float* gn = p.mla_kv_norm + l * 128;
#pragma unroll
        for (int i = 0; i < 8; ++i) v[i] = (k0 < 128) ? gn[k0 + i] * src[(size_t)(k0 + i) * 1024] : 0.f;
    } else if (mat == 4) {
        dst = (bf16_t*)(wl + W_BR) + (size_t)n * 1536 + k0;
        const int br = k0 >> 9, kk = k0 & 511;
        const float* src = (br == 0 ? p.w_bm : (br == 1 ? p.w_bp : p.w_bg)) + (size_t)l * 512 * 1024 + n;
#pragma unroll
        for (int i = 0; i < 8; ++i) v[i] = src[(size_t)(kk + i) * 1024];
    } else if (mat == 5) {
        dst = (bf16_t*)(wl + W_OUT) + (size_t)n * 1024 + k0;
        const float* src = p.w_out + (size_t)l * 1024 * 1024 + n;
#pragma unroll
        for (int i = 0; i < 8; ++i) v[i] = src[(size_t)(k0 + i) * 1024];
    } else {
        dst = (bf16_t*)(wl + W_POOL) + (size_t)n * 128 + k0;
        const int g = n >> 7, o = n & 127;
        const float* src = p.pool_w + (size_t)l * 4 * 128 * 128 + (size_t)g * 128 * 128 + o;
#pragma unroll
        for (int i = 0; i < 8; ++i) v[i] = src[(size_t)(k0 + i) * 128];
    }
    u32x4 o; o.x = cvtpk(v[0], v[1]); o.y = cvtpk(v[2], v[3]); o.z = cvtpk(v[4], v[5]); o.w = cvtpk(v[6], v[7]);
    *(u32x4*)dst = o;
}

__device__ __forceinline__ void modnorm_row(const float* xr, const float* pre_g, const float* modrow, bf16_t* hrow, int l32) {
    f32x4 v[8]; float s = 0.f;
#pragma unroll
    for (int j = 0; j < 4; ++j) { v[2 * j] = *(const f32x4*)(xr + 8 * l32 + 256 * j); v[2 * j + 1] = *(const f32x4*)(xr + 8 * l32 + 256 * j + 4); }
#pragma unroll
    for (int j = 0; j < 8; ++j) s += v[j][0] * v[j][0] + v[j][1] * v[j][1] + v[j][2] * v[j][2] + v[j][3] * v[j][3];
#pragma unroll
    for (int o = 1; o < 32; o <<= 1) s += __shfl_xor(s, o);
    const float rs = __builtin_amdgcn_rsqf(s * (1.f / D) + EPS);
#pragma unroll
    for (int j = 0; j < 4; ++j) { float o[8];
#pragma unroll
        for (int q = 0; q < 2; ++q) { const int c = 8 * l32 + 256 * j + 4 * q;
            const f32x4 g = *(const f32x4*)(pre_g + c), sh = *(const f32x4*)(modrow + c), sc = *(const f32x4*)(modrow + D + c);
#pragma unroll
            for (int e = 0; e < 4; ++e) o[4 * q + e] = v[2 * j + q][e] * rs * g[e] * (1.f + sc[e]) + sh[e]; }
        u32x4 pk; pk.x = cvtpk(o[0], o[1]); pk.y = cvtpk(o[2], o[3]); pk.z = cvtpk(o[4], o[5]); pk.w = cvtpk(o[6], o[7]);
        *(u32x4*)(hrow + 8 * l32 + 256 * j) = pk; }
}

__global__ void __launch_bounds__(512, 2) fwd_kernel(Params p) {
    extern __shared__ __attribute__((aligned(16))) unsigned char lds_raw[];
    LAS unsigned char* lds = (LAS unsigned char*)lds_raw;
    cg::grid_group grid = cg::this_grid();
    const int wid = __builtin_amdgcn_readfirstlane(threadIdx.x >> 6);
    const int G = gridDim.x, bid = blockIdx.x;
    const int vcu = (G % 8 == 0) ? (bid % 8) * (G / 8) + bid / 8 : bid;
    const int gw = bid * 8 + wid, NGW = G * 8;
    unsigned char* ws = p.ws;
    bf16_t* Z = (bf16_t*)(ws + OFF_Z); bf16_t* H = (bf16_t*)(ws + OFF_H); bf16_t* Qb = (bf16_t*)(ws + OFF_Q); bf16_t* KVb = (bf16_t*)(ws + OFF_KV);
    bf16_t* OT = (bf16_t*)(ws + OFF_OT); bf16_t* KR = (bf16_t*)(ws + OFF_KR);
    float* ssq_q = (float*)(ws + OFF_SSQQ); float* ssq_kv = (float*)(ws + OFF_SSQKV); float* modb = (float*)(ws + OFF_MOD); f32x2* tab = (f32x2*)(ws + OFF_TAB);
    const int lo = p.ph_lo, hi_ph = p.ph_hi; const bool dryflag = (p.ph_lo == 0);
    unsigned* barw = (unsigned*)(ws + OFF_BAR);
    XcdBarrier xbar; xbar.bar = barw; xbar.x = 0; xbar.st = (volatile LAS unsigned*)(lds + 147200);
    if (threadIdx.x < 2) ((volatile LAS unsigned*)(lds + 147200))[threadIdx.x] = 0u;
    if (bid == 0) for (int i = threadIdx.x; i < XCD_BAR_WORDS; i += 512) barw[i] = 0u;
    int ph = 0;
#define PHASE_BEGIN if (ph >= lo && ph < hi_ph) { int tid = threadIdx.x; asm volatile("" : "+v"(tid)); const int lane = tid & 63; (void)lane;
#define PHASE_END } ++ph; if (ph > lo && ph < hi_ph) { if (ph == 1) { grid.sync(); xbar = xcd_barrier_post(barw, (volatile LAS unsigned*)(lds + 147200)); } else { xcd_barrier(xbar); if (DUP == 12) { xcd_barrier(xbar); xcd_barrier(xbar); xcd_barrier(xbar); xcd_barrier(xbar); } } }

    PHASE_BEGIN
    for (int rep = (DUP == 10 ? 0 : 1); rep < 2; ++rep) {
        const long gt = (long)bid * 512 + tid, NT = (long)G * 512;
        for (int l = 0; l < 2; ++l) {
            unsigned char* wl = ws + OFF_W + (size_t)l * W_LAYER;
            for (long it = gt; it < 3584L * 128; it += NT) prep_item(p, l, 0, (int)(it % 3584), (int)(it / 3584), wl);
            for (long it = gt; it < 3072L * 128; it += NT) prep_item(p, l, 1, (int)(it % 3072), (int)(it / 3072), wl);
            for (long it = gt; it < 1024L * 32; it += NT) prep_item(p, l, 2, (int)(it % 1024), (int)(it / 1024), wl);
            for (long it = gt; it < 1024L * 32; it += NT) prep_item(p, l, 3, (int)(it % 1024), (int)(it / 1024), wl);
            for (long it = gt; it < 1024L * 192; it += NT) prep_item(p, l, 4, (int)(it % 1024), (int)(it / 1024), wl);
            for (long it = gt; it < 1024L * 128; it += NT) prep_item(p, l, 5, (int)(it % 1024), (int)(it / 1024), wl);
            for (long it = gt; it < 512L * 16; it += NT) prep_item(p, l, 6, (int)(it % 512), (int)(it / 512), wl);
        }
        if (gt < 512) { const int pos = (int)gt >> 3, f = (int)gt & 7; const float inv = exp2f(-(float)f * (13.287712379549449f / 8.f));
            const float rev = (float)pos * inv * 0.15915494309189535f; const float fr_ = rev - floorf(rev);
            f32x2 e; e.x = __builtin_amdgcn_cosf(fr_); e.y = __builtin_amdgcn_sinf(fr_); tab[gt] = e; }
        for (long i = gt; i < M; i += NT) { ssq_q[i] = 0.f; ssq_kv[i] = 0.f; }
        LAS float* sc = (LAS float*)lds;
        for (int i = tid; i < 33 * 1024; i += 512) { const int bb = i >> 10, k = i & 1023; const float cv = (bb < 32) ? p.c[bb * 1024 + k] : p.c_ctx[k]; sc[i] = cv / (1.f + __expf(-cv)); }
        __syncthreads();
        for (int u = bid; u < 192; u += G) {
            const int l = u / 96, cgp = u % 96; const int colq = tid & 31, kg = tid >> 5;
            float a[33];
#pragma unroll
            for (int bb = 0; bb < 33; ++bb) a[bb] = 0.f;
            const float* wp = p.mod_w + (size_t)l * 1024 * 3072 + cgp * 32 + colq;
            for (int k0 = kg * 64; k0 < kg * 64 + 64; k0 += 8) { float w8[8];
#pragma unroll
                for (int q = 0; q < 8; ++q) w8[q] = wp[(size_t)(k0 + q) * 3072];
#pragma unroll
                for (int q = 0; q < 8; ++q)
#pragma unroll
                    for (int bb = 0; bb < 33; ++bb) a[bb] += sc[bb * 1024 + k0 + q] * w8[q]; }
            LAS float* red = (LAS float*)(lds + 135168);
            for (int i = tid; i < 33 * 32; i += 512) red[i] = 0.f;
            __syncthreads();
#pragma unroll
            for (int bb = 0; bb < 33; ++bb) atomicAdd((float*)(red + bb * 32 + colq), a[bb]);
            __syncthreads();
            for (int i = tid; i < 33 * 32; i += 512) { const int bb = i >> 5, cq = i & 31; modb[((size_t)l * 33 + bb) * 3072 + cgp * 32 + cq] = red[i] + p.mod_b[l * 3072 + cgp * 32 + cq]; }
            __syncthreads();
        }
    }
    PHASE_END

    PHASE_BEGIN
    for (int rep = (DUP == 9 ? 0 : 1); rep < 2; ++rep)
    for (int r0 = 2 * gw; r0 < M; r0 += 2 * NGW) { const int r = r0 + (lane >> 5);
        const int b = r / TOK, tok = r % TOK;
        const float* xr = (tok < CTXL) ? p.ctx + ((size_t)b * CTXL + tok) * D : p.x + ((size_t)b * SEQ + tok - CTXL) * D;
        modnorm_row(xr, p.pre_norm, modb + (size_t)((tok < CTXL) ? 32 : b) * 3072, H + (size_t)r * D, lane & 31);
    }
    PHASE_END

    for (int l = 0; l < 2; ++l) {
        unsigned char* wl = ws + OFF_W + (size_t)l * W_LAYER;
        GEpi E; E.Z = Z; E.KR = KR; E.ssq_q = ssq_q; E.ssq_kv = ssq_kv; E.Qb = Qb; E.KVb = KVb; E.gscr = ws + OFF_Q + (size_t)bid * GSCR_PER_WG; E.tab = tab;
        GSched S; S.G = G; S.c = bid; S.Z = (const char*)Z; S.H = (const char*)H; S.W = (const char*)wl;

        PHASE_BEGIN
        S.mode = 0; S.latent_only = (l == 1);
        if (DUP == 1) gemm_phase(lds, S, E, dryflag);
        gemm_phase(lds, S, E, false);
        PHASE_END

        PHASE_BEGIN
        for (int rep = (DUP == 2 ? 0 : 1); rep < 2; ++rep)
        for (int u = vcu; u < 256; u += G) {
            const int b = u >> 3, h = (u >> 1) & 3, dvh = u & 1;
            gla_unit((LAS char*)lds, b, h, dvh, Z, OT, p.af_w2 + l * 16 * 256, p.af_b + l * 256, p.ab_w2 + l * 16 * 256, p.ab_b + l * 256, rep == 0 && dryflag);
        }
        __syncthreads();
        S.mode = 1; S.latent_only = (l == 1);
        if (DUP == 3) gemm_phase(lds, S, E, dryflag);
        gemm_phase(lds, S, E, false);
        for (int rep = (DUP == 4 ? 0 : 1); rep < 2; ++rep)
        for (int u = vcu; u < 288 * 4; u += G) { const int pm = u >> 2, g = u & 3;
            if (l == 1 && pm % 9 == 0) continue;
            pool_unit((LAS char*)lds, pm, g, Z, (const bf16_t*)(wl + W_POOL) + (size_t)g * 128 * 128, p.pool_scale + l * 512, rep == 0 && dryflag); }
        PHASE_END

        PHASE_BEGIN
        for (int rep = (DUP == 11 ? 0 : 1); rep < 2; ++rep)
        for (int r0 = 4 * gw; r0 < M; r0 += 4 * NGW) {
            if (l == 1 && (r0 % TOK) < CTXL) continue;
            const int r = r0 + (lane >> 4), l16 = lane & 15;
            u32x4 ov[4], gv[4];
#pragma unroll
            for (int hh = 0; hh < 4; ++hh) { ov[hh] = *(const u32x4*)(OT + (size_t)r * 512 + hh * 128 + 8 * l16); gv[hh] = *(const u32x4*)(Z + (size_t)r * ZP + ZYG + hh * 128 + 8 * l16); }
            const f32x4 gn0 = *(const f32x4*)(p.gla_norm + l * 128 + 8 * l16), gn1 = *(const f32x4*)(p.gla_norm + l * 128 + 8 * l16 + 4);
#pragma unroll
            for (int hh = 0; hh < 4; ++hh) {
                float o[8] = {bflo(ov[hh].x), bfhi(ov[hh].x), bflo(ov[hh].y), bfhi(ov[hh].y), bflo(ov[hh].z), bfhi(ov[hh].z), bflo(ov[hh].w), bfhi(ov[hh].w)};
                float s = 0.f;
#pragma unroll
                for (int j = 0; j < 8; ++j) s += o[j] * o[j];
                s += __shfl_xor(s, 1); s += __shfl_xor(s, 2); s += __shfl_xor(s, 4); s += __shfl_xor(s, 8);
                const float rs = __builtin_amdgcn_rsqf(s * (1.f / 128.f) + EPS);
                const float gt[8] = {bflo(gv[hh].x), bfhi(gv[hh].x), bflo(gv[hh].y), bfhi(gv[hh].y), bflo(gv[hh].z), bfhi(gv[hh].z), bflo(gv[hh].w), bfhi(gv[hh].w)};
                u32x4 ow; ow.x = cvtpk(o[0] * rs * gn0[0] * gt[0], o[1] * rs * gn0[1] * gt[1]); ow.y = cvtpk(o[2] * rs * gn0[2] * gt[2], o[3] * rs * gn0[3] * gt[3]);
                ow.z = cvtpk(o[4] * rs * gn1[0] * gt[4], o[5] * rs * gn1[1] * gt[5]); ow.w = cvtpk(o[6] * rs * gn1[2] * gt[6], o[7] * rs * gn1[3] * gt[7]);
                if (!(rep == 0 && dryflag)) *(u32x4*)(Z + (size_t)r * ZP + ZYG + hh * 128 + 8 * l16) = ow;
            }
        }
        __syncthreads();
        {
            const int nlat = 2048, nctx = (l == 0) ? 256 : 0;
            for (int rep = (DUP == 5 ? 0 : 1); rep < 2; ++rep)
            for (int u = vcu; u < nlat + nctx; u += G) { const bool dry = (rep == 0) && dryflag;
                if (u < nlat) { const int bh = u >> 3, qb = u & 7, b = bh >> 3, h = bh & 7; const size_t q0 = (size_t)b * TOK + CTXL + qb * 256, k0 = (size_t)b * TOK;
                    attn_unit((LAS char*)lds, Qb + q0 * 768 + h * 96, KVb + k0 * 1024 + h * 64, KR + k0 * 32, 36, Z + q0 * ZP + ZYM + h * 64, dry); }
                else { const int bh = u - nlat, b = bh >> 3, h = bh & 7; const size_t q0 = (size_t)b * TOK;
                    attn_unit((LAS char*)lds, Qb + q0 * 768 + h * 96, KVb + q0 * 1024 + h * 64, KR + q0 * 32, 4, Z + q0 * ZP + ZYM + h * 64, dry); }
            }
        }
        PHASE_END

        PHASE_BEGIN
        S.mode = 2; S.latent_only = (l == 1);
        if (DUP == 6) gemm_phase(lds, S, E, dryflag);
        if (DUP == 13) gemm_phase(lds, S, E, !dryflag);
        gemm_phase(lds, S, E, false);
        PHASE_END

        PHASE_BEGIN
        S.mode = 3; S.latent_only = (l == 1);
        if (DUP == 7) gemm_phase(lds, S, E, dryflag);
        gemm_phase(lds, S, E, false);
        PHASE_END

        PHASE_BEGIN
        for (int rep = (DUP == 8 ? 0 : 1); rep < 2; ++rep)
        for (int r0 = 2 * gw; r0 < M; r0 += 2 * NGW) { const bool dry = (rep == 0) && dryflag;
            const int l32 = lane & 31; const int r = r0 + (lane >> 5);
            const int b = r / TOK, tok = r % TOK; const bool isctx = tok < CTXL;
            if (l == 1 && (r0 % TOK) < CTXL) continue;
            const bf16_t* orow = Z + (size_t)r * ZP + 1024;
            const float* xr = (l == 0) ? (isctx ? p.ctx + ((size_t)b * CTXL + tok) * D : p.x + ((size_t)b * SEQ + tok - CTXL) * D) : p.out + ((size_t)b * SEQ + tok - CTXL) * D;
            const float* mrow = modb + ((size_t)l * 33 + (isctx ? 32 : b)) * 3072;
            u32x4 t4[4]; f32x4 xv[8];
#pragma unroll
            for (int j = 0; j < 4; ++j) { t4[j] = *(const u32x4*)(orow + 8 * l32 + 256 * j); xv[2 * j] = *(const f32x4*)(xr + 8 * l32 + 256 * j); xv[2 * j + 1] = *(const f32x4*)(xr + 8 * l32 + 256 * j + 4); }
            float ov[32]; float s = 0.f;
#pragma unroll
            for (int j = 0; j < 4; ++j) {
                ov[8 * j + 0] = bflo(t4[j].x); ov[8 * j + 1] = bfhi(t4[j].x); ov[8 * j + 2] = bflo(t4[j].y); ov[8 * j + 3] = bfhi(t4[j].y); ov[8 * j + 4] = bflo(t4[j].z); ov[8 * j + 5] = bfhi(t4[j].z); ov[8 * j + 6] = bflo(t4[j].w); ov[8 * j + 7] = bfhi(t4[j].w); }
#pragma unroll
            for (int j = 0; j < 32; ++j) s += ov[j] * ov[j];
#pragma unroll
            for (int o = 1; o < 32; o <<= 1) s += __shfl_xor(s, o);
            const float rs = __builtin_amdgcn_rsqf(s * (1.f / D) + EPS);
            float s2 = 0.f;
#pragma unroll
            for (int j = 0; j < 4; ++j)
#pragma unroll
                for (int q = 0; q < 2; ++q) { const int c = 8 * l32 + 256 * j + 4 * q;
                    const f32x4 pg = *(const f32x4*)(p.post_norm + l * D + c), gt = *(const f32x4*)(mrow + 2 * D + c);
#pragma unroll
                    for (int e = 0; e < 4; ++e) { const float v = xv[2 * j + q][e] + gt[e] * ov[8 * j + 4 * q + e] * rs * pg[e]; ov[8 * j + 4 * q + e] = v; s2 += v * v; } }
            if (!isctx && !dry) { float* orw = p.out + ((size_t)b * SEQ + tok - CTXL) * D;
#pragma unroll
                for (int j = 0; j < 4; ++j)
#pragma unroll
                    for (int q = 0; q < 2; ++q) *(f32x4*)(orw + 8 * l32 + 256 * j + 4 * q) = (f32x4){ov[8 * j + 4 * q], ov[8 * j + 4 * q + 1], ov[8 * j + 4 * q + 2], ov[8 * j + 4 * q + 3]}; }
            if (l == 0) {
#pragma unroll
                for (int o = 1; o < 32; o <<= 1) s2 += __shfl_xor(s2, o);
                if (!dry) {
                const float rs2 = __builtin_amdgcn_rsqf(s2 * (1.f / D) + EPS);
                const float* m1 = modb + ((size_t)33 + (isctx ? 32 : b)) * 3072;
#pragma unroll
                for (int j = 0; j < 4; ++j) { float hv[8];
#pragma unroll
                    for (int q = 0; q < 2; ++q) { const int c = 8 * l32 + 256 * j + 4 * q;
                        const f32x4 g = *(const f32x4*)(p.pre_norm + D + c), sh = *(const f32x4*)(m1 + c), scl = *(const f32x4*)(m1 + D + c);
#pragma unroll
                        for (int e = 0; e < 4; ++e) hv[4 * q + e] = ov[8 * j + 4 * q + e] * rs2 * g[e] * (1.f + scl[e]) + sh[e]; }
                    u32x4 hw; hw.x = cvtpk(hv[0], hv[1]); hw.y = cvtpk(hv[2], hv[3]); hw.z = cvtpk(hv[4], hv[5]); hw.w = cvtpk(hv[6], hv[7]);
                    *(u32x4*)(H + (size_t)r * D + 8 * l32 + 256 * j) = hw; }
                if (l32 == 0) { ssq_q[r] = 0.f; ssq_kv[r] = 0.f; }
                }
            }
        }
        PHASE_END
    }
}

extern "C" void kernel_launch(void* const* d_in, const int* in_sizes, int n_in, void* d_out, int out_size, void* d_ws, size_t ws_size, hipStream_t stream) {
    static int grid = 0;
    if (grid == 0) {
        if (n_in != 24 || ws_size < WS_END) { fprintf(stderr, "kernel_launch: bad inputs n_in=%d ws=%zu need %zu\n", n_in, ws_size, (size_t)WS_END); grid = -1; return; }
        int dev = 0, cus = 0, per_cu = 0;
        hipGetDevice(&dev); hipDeviceGetAttribute(&cus, hipDeviceAttributeMultiprocessorCount, dev);
        hipFuncSetAttribute((const void*)fwd_kernel, hipFuncAttributeMaxDynamicSharedMemorySize, LDS_BYTES);
        hipOccupancyMaxActiveBlocksPerMultiprocessor(&per_cu, (const void*)fwd_kernel, 512, LDS_BYTES);
        if (per_cu < 1) { fprintf(stderr, "kernel_launch: occupancy query returned %d\n", per_cu); per_cu = 1; }
        (void)hipGetLastError();
        grid = cus < 256 ? cus : 256;
    }
    if (grid < 0) return;
    Params p{};
    const float** f = (const float**)&p;
    for (int i = 0; i < 24; ++i) f[i] = (const float*)d_in[i];
    p.out = (float*)d_out; p.ws = (unsigned char*)d_ws; p.ph_lo = 0; p.ph_hi = 1000;
    void* args[] = {&p};
    hipError_t e = hipLaunchCooperativeKernel((const void*)fwd_kernel, dim3(grid), dim3(512), args, LDS_BYTES, stream);
    if (e != hipSuccess) fprintf(stderr, "cooperative launch failed: %s (grid %d)\n", hipGetErrorString(e), grid);
}
```

```cpp
#include <hip/hip_runtime.h>
#include <hip/hip_cooperative_groups.h>
#include <cstdio>
#include <cstdint>
namespace cg = cooperative_groups;

#define LAS __attribute__((address_space(3)))
typedef unsigned short bf16_t;
typedef short bf16x8 __attribute__((ext_vector_type(8)));
typedef short s16x4 __attribute__((ext_vector_type(4)));
typedef float f32x4 __attribute__((ext_vector_type(4)));
typedef float f32x2 __attribute__((ext_vector_type(2)));
typedef float f32x16 __attribute__((ext_vector_type(16)));
typedef unsigned u32x4 __attribute__((ext_vector_type(4)));
typedef unsigned u32x2 __attribute__((ext_vector_type(2)));
typedef __bf16 bf16x2_t __attribute__((ext_vector_type(2)));

constexpr int NB = 32, SEQ = 2048, CTXL = 256, TOK = 2304, M = NB * TOK, D = 1024, DIN = 6592, ZP = 3584;
constexpr int ZQ = 0, ZKV = 256, ZPX = 512, ZGQ = 1024, ZGK = 1280, ZGV = 1536, ZYM = 2048, ZYP = 2560, ZYG = 3072;
constexpr int ZAF = ZKV + 192, ZAB = ZKV + 208;
constexpr float EPS = 1e-6f;
constexpr float QSCALE = 0.10206207261596577f * 1.4426950408889634f;
constexpr int C_MQ = 0, C_MKV = 256, C_MKR = 384, C_MG = 416, C_PX = 928, C_PG = 1440, C_GQ = 1952, C_GK = 2208, C_GV = 2464, C_AF = 2976, C_AB = 2992, C_GG = 3008, C_MRG = 3520;

constexpr size_t SZ_Z = (size_t)M * ZP * 2, SZ_H = (size_t)M * D * 2, SZ_Q = (size_t)M * 768 * 2, SZ_KV = (size_t)M * 1024 * 2, SZ_OT = (size_t)M * 512 * 2, SZ_KR = (size_t)M * 32 * 2;
constexpr size_t OFF_Z = 0, OFF_H = OFF_Z + SZ_Z, OFF_Q = OFF_H + SZ_H, OFF_KV = OFF_Q + SZ_Q, OFF_OT = OFF_KV + SZ_KV, OFF_KR = OFF_OT + SZ_OT, OFF_W = OFF_KR + SZ_KR;
constexpr size_t W_IN = 0, W_M = W_IN + 3584 * 1024 * 2, W_UQ = W_M + 3072 * 1024 * 2, W_UKV = W_UQ + 1024 * 256 * 2, W_BR = W_UKV + 1024 * 256 * 2, W_OUT = W_BR + 1024 * 1536 * 2, W_POOL = W_OUT + 1024 * 1024 * 2, W_LAYER = W_POOL + 4 * 128 * 128 * 2;
constexpr size_t OFF_SSQQ = OFF_W + 2 * W_LAYER, OFF_SSQKV = OFF_SSQQ + (size_t)M * 4, OFF_MOD = OFF_SSQKV + (size_t)M * 4, OFF_TAB = OFF_MOD + 2 * 33 * 3072 * 4, OFF_BAR = OFF_TAB + 64 * 8 * 8, WS_END = OFF_BAR + 16384;
constexpr size_t GSCR_PER_WG = 3 * 16 * 512 * 16;
static_assert(256 * GSCR_PER_WG <= SZ_Q, "gate scratch overlays Q");
static_assert(WS_END <= (size_t)1 << 30, "workspace");

constexpr int LDS_BYTES = 147456;
#ifndef DUP
#define DUP 0
#endif

__device__ __forceinline__ unsigned cvtpk(float lo, float hi) { f32x2 v = {lo, hi}; bf16x2_t b = __builtin_convertvector(v, bf16x2_t); return __builtin_bit_cast(unsigned, b); }
__device__ __forceinline__ bf16_t f2bf(float f) { return (bf16_t)(cvtpk(f, 0.f) & 0xffffu); }
__device__ __forceinline__ float bf2f(bf16_t b) { return __uint_as_float(((unsigned)b) << 16); }
__device__ __forceinline__ float bflo(unsigned u) { return __uint_as_float(u << 16); }
__device__ __forceinline__ float bfhi(unsigned u) { return __uint_as_float(u & 0xffff0000u); }
__device__ __forceinline__ float fexp2(float x) { return __builtin_amdgcn_exp2f(x); }
__device__ __forceinline__ float fexp(float x) { return __builtin_amdgcn_exp2f(x * 1.4426950408889634f); }
__device__ __forceinline__ float frcp(float x) { return __builtin_amdgcn_rcpf(x); }
__device__ __forceinline__ float sigmoidf_(float x) { return frcp(1.f + fexp(-x)); }
__device__ __forceinline__ float siluf_(float x) { return x * sigmoidf_(x); }
__device__ __forceinline__ float wave_sum(float v) {
#pragma unroll
    for (int o = 1; o < 64; o <<= 1) v += __shfl_xor(v, o);
    return v;
}
__device__ __forceinline__ int crow(int r, int hi) { return (r & 3) + 8 * (r >> 2) + 4 * hi; }
__device__ __forceinline__ u32x4 pack8(f32x4 a, f32x4 b) { u32x4 o; o.x = cvtpk(a[0], a[1]); o.y = cvtpk(a[2], a[3]); o.z = cvtpk(b[0], b[1]); o.w = cvtpk(b[2], b[3]); return o; }
__device__ __forceinline__ s16x4 trread(const LAS char* p) { return __builtin_bit_cast(s16x4, __builtin_amdgcn_ds_read_tr16_b64_v4i16((LAS s16x4*)p)); }
#define MK8(lo, hi) (bf16x8){lo[0], lo[1], lo[2], lo[3], hi[0], hi[1], hi[2], hi[3]}


#define XB_TMO      128
#define XB_XCNT(j)  (256  + 64 * (j))
#define XB_XSUB(j)  (1280 + 64 * (j))
#define XB_XGEN(j)  (2304 + 64 * (j))
#define XB_TOP      3328
#define XB_TOPGEN   3392
#define XCD_BAR_WORDS 3456
#define XB_SPIN_CAP (1u << 18)
__device__ __forceinline__ unsigned xb_ld(unsigned* p)              { return __hip_atomic_load(p, __ATOMIC_RELAXED, __HIP_MEMORY_SCOPE_AGENT); }
__device__ __forceinline__ unsigned xb_add(unsigned* p, unsigned v) { return __hip_atomic_fetch_add(p, v, __ATOMIC_RELAXED, __HIP_MEMORY_SCOPE_AGENT); }
__device__ __forceinline__ unsigned xb_xcc_id() { return (unsigned)__builtin_amdgcn_s_getreg((3 << 11) | 20) & 0xFu; }
#define XB_SPIN(cond, bar) do { unsigned _sp = 0; while (cond) { __builtin_amdgcn_s_sleep(1); \
    if ((++_sp & 255u) == 0u) { if (xb_ld(&(bar)[XB_TMO])) break; if (_sp > XB_SPIN_CAP) { atomicAdd(&(bar)[XB_TMO], 1u); break; } } } } while (0)
struct XcdBarrier { unsigned* bar; unsigned x; volatile LAS unsigned* st; };
__device__ __forceinline__ XcdBarrier xcd_barrier_post(unsigned* bar, volatile LAS unsigned* st) {
    XcdBarrier b; b.bar = bar; b.x = xb_xcc_id(); b.st = st;
    if (threadIdx.x == 0) (void)xb_add(&bar[XB_XCNT(b.x)], 1u);
    return b;
}
__device__ __forceinline__ void xcd_barrier_complete(unsigned* bar, unsigned x, unsigned& nloc, unsigned& nx) {
    const unsigned G = gridDim.x * gridDim.y * gridDim.z;
    unsigned sum, cnt, mine, sp = 0u;
    for (;;) {
        sum = 0u; cnt = 0u; mine = 0u;
#pragma unroll
        for (unsigned j = 0; j < 16; ++j) { const unsigned c = xb_ld(&bar[XB_XCNT(j)]); sum += c; cnt += (c > 0u) ? 1u : 0u; mine = (j == x) ? c : mine; }
        if (sum == G) break;
        __builtin_amdgcn_s_sleep(1);
        if ((++sp & 255u) == 0u) { if (xb_ld(&bar[XB_TMO])) break; if (sp > XB_SPIN_CAP) { atomicAdd(&bar[XB_TMO], 1u); break; } }
    }
    nloc = mine > 0u ? mine : 1u; nx = cnt > 0u ? cnt : 1u;
}
__device__ __forceinline__ void xcd_barrier(const XcdBarrier& b) {
    asm volatile("s_waitcnt vmcnt(0)" ::: "memory");
    __syncthreads();
    if (threadIdx.x == 0) {
        unsigned* bar = b.bar;
        __builtin_amdgcn_s_waitcnt(0);
        unsigned nloc = b.st[0], nx = b.st[1];
        if (nloc == 0u) { xcd_barrier_complete(bar, b.x, nloc, nx); b.st[0] = nloc; b.st[1] = nx; }
        const unsigned old = xb_add(&bar[XB_XSUB(b.x)], 1u);
        const unsigned gen = old / nloc;
        if (old + 1u == (gen + 1u) * nloc) {
            __builtin_amdgcn_fence(__ATOMIC_RELEASE, "agent");
            asm volatile("s_waitcnt vmcnt(0)" ::: "memory");
            const unsigned og = xb_add(&bar[XB_TOP], 1u);
            const unsigned tg = og / nx;
            if (og + 1u == (tg + 1u) * nx) xb_add(&bar[XB_TOPGEN], 1u);
            else XB_SPIN(xb_ld(&bar[XB_TOPGEN]) == tg, bar);
            __builtin_amdgcn_fence(__ATOMIC_ACQUIRE, "agent");
            xb_add(&bar[XB_XGEN(b.x)], 1u);
            asm volatile("s_waitcnt vmcnt(0)" ::: "memory");
        } else {
            XB_SPIN(xb_ld(&bar[XB_XGEN(b.x)]) == gen, bar);
            __builtin_amdgcn_fence(__ATOMIC_ACQUIRE, "agent");
            asm volatile("s_waitcnt vmcnt(0)" ::: "memory");
        }
    }
    __syncthreads();
}

struct Params {
    const float* x; const float* c; const float* ctx; const float* c_ctx; const float* mod_w; const float* mod_b; const float* pre_norm; const float* post_norm;
    const float* w_in; const float* mla_q_norm; const float* mla_w_uq; const float* mla_kv_norm; const float* mla_w_ukv; const float* pool_w; const float* pool_scale;
    const float* af_w2; const float* af_b; const float* ab_w2; const float* ab_b; const float* gla_norm; const float* w_bm; const float* w_bp; const float* w_bg; const float* w_out;
    float* out; unsigned char* ws; int ph_lo, ph_hi;
};

constexpr int BK = 64, HALF = 128, HTB = HALF * BK * 2;
__device__ __forceinline__ int lds_byte(int r, int c) { const int st = (r >> 4) * 2 + (c >> 5), rr = r & 15, cc = c & 31, ob = rr * 64 + cc * 2; return st * 1024 + (ob ^ (((ob >> 9) & 1) << 5)); }
__device__ __forceinline__ void stage_rc(int b, int& R, int& C) { const int st = b / 1024, sb = b % 1024, swz = sb ^ (((sb >> 9) & 1) << 5); R = (st >> 1) * 16 + swz / 64; C = (st & 1) * 32 + (swz % 64) / 2; }
__device__ __forceinline__ int perm32(int rho) { const int n = rho >> 4, i = rho & 15; return 8 * (i >> 2) + 4 * n + (i & 3); }

enum { EP_ZIN = 0, EP_Q = 1, EP_KV = 2, EP_GATE = 3, EP_MERGE = 4, EP_OUT = 5 };
struct GUnit { const char* A; const char* B; int lda2; int nt; int kind; int pm; int pn; int aux; };

__device__ __forceinline__ bool tile_of(long L, int nM, int nN, int& pm, int& pn) {
    const int nwg = nM * nN; if (L >= nwg) return false;
    int wgid = (int)L; { const int q = nwg / 8, r = nwg % 8, xcd = wgid % 8, off = wgid / 8; wgid = (xcd < r ? xcd * (q + 1) : r * (q + 1) + (xcd - r) * q) + off; }
    const int nig = 8 * nN, gid = wgid / nig, fm = gid * 8, gsz = (nM - fm) < 8 ? (nM - fm) : 8;
    pm = fm + ((wgid % nig) % gsz); pn = (wgid % nig) / gsz; return true;
}

struct GSched {
    int mode;
    int G, c; int latent_only;
    const char* Z; const char* H; const char* W;
    __device__ __forceinline__ int rowtile(int lt) const { return latent_only ? ((lt >> 3) * 9 + 1 + (lt & 7)) : lt; }
    __device__ __forceinline__ int nrt() const { return latent_only ? 256 : 288; }
    __device__ __forceinline__ bool next(int i, GUnit& u) const {
        int pm, pn;
        if (mode == 0) {
            if (latent_only) {
                const long L = (long)i * G + c;
                if (L < 256 * 14) { tile_of(L, 256, 14, pm, pn); pm = rowtile(pm); }
                else { const int L2 = (int)(L - 256 * 14); if (L2 >= 128) return false; pm = (L2 >> 2) * 9; const int q = L2 & 3; pn = (q == 0) ? 1 : (4 + q); }
            } else
            if (!tile_of((long)i * G + c, 288, 14, pm, pn)) return false;
            u.A = H + (size_t)pm * 256 * 2048; u.lda2 = 2048; u.B = W + W_IN + (size_t)pn * 256 * 2048; u.nt = 16; u.kind = EP_ZIN; u.pm = pm; u.pn = pn; u.aux = 0; return true;
        } else if (mode == 1) {
            const long L = (long)i * G + c; const int nq = nrt() * 4;
            if (L < nq) { tile_of(L, nrt(), 4, pm, pn); pm = rowtile(pm);
                u.A = Z + (size_t)pm * 256 * (ZP * 2) + ZQ * 2; u.lda2 = ZP * 2; u.B = W + W_UQ + (size_t)pn * 256 * 512; u.nt = 4; u.kind = EP_Q; u.pm = pm; u.pn = pn; u.aux = 0; return true; }
            if (!tile_of(L - nq, 288, 4, pm, pn)) return false;
            u.A = Z + (size_t)pm * 256 * (ZP * 2) + ZKV * 2; u.lda2 = ZP * 2; u.B = W + W_UKV + (size_t)pn * 256 * 512; u.nt = 4; u.kind = EP_KV; u.pm = pm; u.pn = pn; u.aux = 0; return true;
        } else if (mode == 2) {
            const int grp = i >> 2, sub = i & 3;
            if (!tile_of((long)grp * G + c, nrt(), 4, pm, pn)) return false;
            pm = rowtile(pm); u.pm = pm; u.pn = pn; u.aux = sub;
            if (sub < 3) { u.A = H + (size_t)pm * 256 * 2048; u.lda2 = 2048; u.B = W + W_M + (size_t)(sub * 1024 + pn * 256) * 2048; u.nt = 16; u.kind = EP_GATE; }
            else { u.A = Z + (size_t)pm * 256 * (ZP * 2) + ZYM * 2; u.lda2 = ZP * 2; u.B = W + W_BR + (size_t)pn * 256 * 3072; u.nt = 24; u.kind = EP_MERGE; }
            return true;
        } else {
            if (!tile_of((long)i * G + c, nrt(), 4, pm, pn)) return false;
            pm = rowtile(pm);
            u.A = Z + (size_t)pm * 256 * (ZP * 2); u.lda2 = ZP * 2; u.B = W + W_OUT + (size_t)pn * 256 * 2048; u.nt = 16; u.kind = EP_OUT; u.pm = pm; u.pn = pn; u.aux = 0; return true;
        }
    }
};

struct GEpi {
    bf16_t* Z; bf16_t* KR; float* ssq_q; float* ssq_kv; bf16_t* Qb; bf16_t* KVb; unsigned char* gscr; const f32x2* tab;
    __device__ __forceinline__ void mid(f32x4 (&acc)[2][2][4][2], int which, int tid) const {
        unsigned t16 = (unsigned)tid * 16u; asm volatile("" : "+v"(t16));
#pragma unroll
        for (int ab = 0; ab < 4; ++ab) {
            u32x4 ga[4], gb[4];
#pragma unroll
            for (int m = 0; m < 4; ++m) { const unsigned char* sb = gscr + (size_t)((which * 16 + ab * 4 + m) * 8192);
                ga[m] = *(const u32x4*)(sb + t16); gb[m] = *(const u32x4*)(sb + 16 * 8192 + t16); }
            __builtin_amdgcn_sched_barrier(0);
#pragma unroll
            for (int m = 0; m < 4; ++m) { f32x4& a0 = acc[ab >> 1][ab & 1][m][0]; f32x4& a1 = acc[ab >> 1][ab & 1][m][1];
                a0[0] *= (1.f + bflo(gb[m].x)) * frcp(1.f + bflo(ga[m].x)); a0[1] *= (1.f + bfhi(gb[m].x)) * frcp(1.f + bfhi(ga[m].x));
                a0[2] *= (1.f + bflo(gb[m].y)) * frcp(1.f + bflo(ga[m].y)); a0[3] *= (1.f + bfhi(gb[m].y)) * frcp(1.f + bfhi(ga[m].y));
                a1[0] *= (1.f + bflo(gb[m].z)) * frcp(1.f + bflo(ga[m].z)); a1[1] *= (1.f + bfhi(gb[m].z)) * frcp(1.f + bfhi(ga[m].z));
                a1[2] *= (1.f + bflo(gb[m].w)) * frcp(1.f + bflo(ga[m].w)); a1[3] *= (1.f + bfhi(gb[m].w)) * frcp(1.f + bfhi(ga[m].w)); }
            __builtin_amdgcn_sched_barrier(0);
        }
    }
    __device__ __forceinline__ void operator()(f32x4 (&acc)[2][2][4][2], const GUnit& u, int wr, int wc, int fr, int fq, int tid) const {
        const int k = u.kind;
        if (k == EP_ZIN) run<EP_ZIN>(acc, u, wr, wc, fr, fq, tid); else if (k == EP_Q) run<EP_Q>(acc, u, wr, wc, fr, fq, tid); else if (k == EP_KV) run<EP_KV>(acc, u, wr, wc, fr, fq, tid);
        else if (k == EP_GATE) run<EP_GATE>(acc, u, wr, wc, fr, fq, tid); else if (k == EP_MERGE) run<EP_MERGE>(acc, u, wr, wc, fr, fq, tid); else run<EP_OUT>(acc, u, wr, wc, fr, fq, tid);
    }
    template <int KIND> __device__ __forceinline__ void run(f32x4 (&acc)[2][2][4][2], const GUnit& u, int wr, int wc, int fr, int fq, int tid) const {
        constexpr int kind = KIND; const int pn = u.pn;
        unsigned t16 = (unsigned)tid * 16u; asm volatile("" : "+v"(t16));
        u32x4 ggv[16];
        if (kind == EP_MERGE) {
#pragma unroll
            for (int i = 0; i < 16; ++i) ggv[i] = *(const u32x4*)(gscr + (size_t)((2 * 16 + i) * 8192) + t16);
        } else {
#pragma unroll
            for (int i = 0; i < 16; ++i) ggv[i] = (u32x4){0u, 0u, 0u, 0u}; }
        __builtin_amdgcn_sched_barrier(0);
#pragma unroll
        for (int ai = 0; ai < 2; ++ai)
#pragma unroll
            for (int m = 0; m < 4; ++m) {
                const int row = u.pm * 256 + ai * 128 + wr * 64 + m * 16 + fr;
                if (kind == EP_ZIN) {
                    const int act = (pn == 4) ? 1 : (pn >= 8 ? 2 : 0);
                    float ss0 = 0.f, ss1 = 0.f;
#pragma unroll
                    for (int bj = 0; bj < 2; ++bj) {
                        f32x4 v0 = acc[ai][bj][m][0], v1 = acc[ai][bj][m][1];
                        if (act == 1) { v0 *= 0.125f; v1 *= 0.125f; }
                        if (act == 2) {
#pragma unroll
                            for (int j = 0; j < 4; ++j) { v0[j] = siluf_(v0[j]); v1[j] = siluf_(v1[j]); } }
                        *(u32x4*)(Z + (size_t)row * ZP + pn * 256 + bj * 128 + wc * 32 + 8 * fq) = pack8(v0, v1);
                        if (pn <= 1) { float s = 0.f;
#pragma unroll
                            for (int j = 0; j < 4; ++j) s += v0[j] * v0[j] + v1[j] * v1[j];
                            if (bj == 0) ss0 = s; else ss1 = s; }
                    }
                    if (pn <= 1) {
                        float s = (pn == 0) ? (ss0 + ss1) : ss0;
                        s += __shfl_xor(s, 16); s += __shfl_xor(s, 32);
                        if (fq == 0) atomicAdd((pn == 0 ? ssq_q : ssq_kv) + row, s);
                        if (pn == 1 && wc < 2) {
                            const f32x4 mn = acc[ai][1][m][0], rt = acc[ai][1][m][1]; f32x4 o = mn;
                            const int tok = row % TOK;
                            if (tok >= CTXL) { const int t = tok - CTXL; const int pos = (wc == 0) ? (t >> 6) : (t & 63);
#pragma unroll
                                for (int j = 0; j < 4; ++j) { const float rv = (float)pos * (fexp2(-(float)(4 * (fq & 1) + j) * (13.287712379549449f / 8.f)) * 0.15915494309189535f);     const float fr_ = rv - floorf(rv); o[j] = mn[j] * __builtin_amdgcn_cosf(fr_) + rt[j] * __builtin_amdgcn_sinf(fr_); } }
                            u32x2 pk; pk.x = cvtpk(o[0], o[1]); pk.y = cvtpk(o[2], o[3]);
                            *(u32x2*)(KR + (size_t)row * 32 + 4 * (4 * wc + fq)) = pk;
                        }
                    }
                } else if (kind == EP_Q) {
                    const float rs = __builtin_amdgcn_rsqf(ssq_q[row] * (1.f / 256.f) + EPS) * QSCALE;
                    const int tok = row % TOK;
#pragma unroll
                    for (int bj = 0; bj < 2; ++bj) {
                        const int head = 2 * pn + bj;
                        f32x4 v0 = acc[ai][bj][m][0] * rs, v1 = acc[ai][bj][m][1] * rs;
                        if (wc < 2) { *(u32x4*)(Qb + (size_t)row * 768 + head * 96 + wc * 32 + 8 * fq) = pack8(v0, v1); }
                        else { f32x4 o = v0; const int g = 4 * (wc - 2) + fq;
                            if (tok >= CTXL) { const int t = tok - CTXL; const int pos = (wc == 2) ? (t >> 6) : (t & 63);
#pragma unroll
                                for (int j = 0; j < 4; ++j) { const float rv = (float)pos * (fexp2(-(float)(4 * (fq & 1) + j) * (13.287712379549449f / 8.f)) * 0.15915494309189535f);     const float fr_ = rv - floorf(rv); o[j] = v0[j] * __builtin_amdgcn_cosf(fr_) + v1[j] * __builtin_amdgcn_sinf(fr_); } }
                            u32x2 pk; pk.x = cvtpk(o[0], o[1]); pk.y = cvtpk(o[2], o[3]);
                            *(u32x2*)(Qb + (size_t)row * 768 + head * 96 + 64 + 4 * g) = pk; }
                    }
                } else if (kind == EP_KV) {
                    const float rs = __builtin_amdgcn_rsqf(ssq_kv[row] * (1.f / 128.f) + EPS);
#pragma unroll
                    for (int bj = 0; bj < 2; ++bj)
                        *(u32x4*)(KVb + (size_t)row * 1024 + pn * 256 + bj * 128 + wc * 32 + 8 * fq) = pack8(acc[ai][bj][m][0] * rs, acc[ai][bj][m][1] * rs);
                } else if (kind == EP_GATE) {
#pragma unroll
                    for (int bj = 0; bj < 2; ++bj) { f32x4 v0 = acc[ai][bj][m][0], v1 = acc[ai][bj][m][1];
#pragma unroll
                        for (int j = 0; j < 4; ++j) { v0[j] = fminf(fexp(-v0[j]), 1e18f); v1[j] = fminf(fexp(-v1[j]), 1e18f); }
                        *(u32x4*)(gscr + (size_t)((u.aux * 16 + (ai * 2 + bj) * 4 + m) * 8192) + t16) = pack8(v0, v1); }
                } else if (kind == EP_MERGE) {
#pragma unroll
                    for (int bj = 0; bj < 2; ++bj) {
                        const u32x4 gg = ggv[(ai * 2 + bj) * 4 + m];
                        f32x4 v0 = acc[ai][bj][m][0], v1 = acc[ai][bj][m][1];
                        v0[0] *= frcp(1.f + bflo(gg.x)); v0[1] *= frcp(1.f + bfhi(gg.x)); v0[2] *= frcp(1.f + bflo(gg.y)); v0[3] *= frcp(1.f + bfhi(gg.y));
                        v1[0] *= frcp(1.f + bflo(gg.z)); v1[1] *= frcp(1.f + bfhi(gg.z)); v1[2] *= frcp(1.f + bflo(gg.w)); v1[3] *= frcp(1.f + bfhi(gg.w));
                        *(u32x4*)(Z + (size_t)row * ZP + pn * 256 + bj * 128 + wc * 32 + 8 * fq) = pack8(v0, v1); }
                } else {
#pragma unroll
                    for (int bj = 0; bj < 2; ++bj)
                        *(u32x4*)(Z + (size_t)row * ZP + 1024 + pn * 256 + bj * 128 + wc * 32 + 8 * fq) = pack8(acc[ai][bj][m][0], acc[ai][bj][m][1]);
                }
                __builtin_amdgcn_sched_barrier(0);
            }
    }
};

__device__ __forceinline__ void gemm_phase(LAS unsigned char* lds, const GSched& S, const GEpi& E, bool dry) {
    int tid = threadIdx.x; asm volatile("" : "+v"(tid)); const int wid = __builtin_amdgcn_readfirstlane(tid >> 6), lane = tid & 63, wr = wid >> 2, wc = wid & 3, fr = lane & 15, fq = lane >> 4;
    int R0, C0; stage_rc(tid * 16, R0, C0);
    const int Rb0 = (R0 & ~31) + perm32(R0 & 31); const int C02 = C0 * 2;
    const unsigned ldsw = (unsigned)wid * 1024u;
    const int aoff = lds_byte(wr * 64 + fr, fq * 8), boff = lds_byte(wc * 32 + fr, fq * 8);
#define PG8_SA(b, h) (((b) * 2 + (h)) * HTB)
#define PG8_SB(b, h) ((4 + (b) * 2 + (h)) * HTB)
#define PG8_STAGE(bufoff, gbase, ld, rowv) do { const unsigned _v = (unsigned)((rowv) * (ld) + C02); \
        __builtin_amdgcn_global_load_lds((const unsigned*)((const char*)(gbase) + _v), (LAS unsigned*)(lds + (bufoff) + ldsw), 16, 0, 0); \
        __builtin_amdgcn_global_load_lds((const unsigned*)((const char*)(gbase) + (size_t)64 * (ld) + _v), (LAS unsigned*)(lds + (bufoff) + ldsw + 8192), 16, 0, 0); } while (0)
#define PG8_LDA(dst, b, h) do { _Pragma("unroll") for (int m = 0; m < 4; ++m) _Pragma("unroll") for (int k = 0; k < 2; ++k) dst[m][k] = *(const LAS bf16x8*)(lds + PG8_SA(b, h) + aoff + m * 2048 + k * 1024); } while (0)
#define PG8_LDB(dst, b, h) do { _Pragma("unroll") for (int n = 0; n < 2; ++n) _Pragma("unroll") for (int k = 0; k < 2; ++k) dst[n][k] = *(const LAS bf16x8*)(lds + PG8_SB(b, h) + boff + n * 2048 + k * 1024); } while (0)
#define PG8_MMA(ai, bj, At, Bt) do { __builtin_amdgcn_s_setprio(1); _Pragma("unroll") for (int m = 0; m < 4; ++m) _Pragma("unroll") for (int n = 0; n < 2; ++n) _Pragma("unroll") for (int k = 0; k < 2; ++k) \
        acc[ai][bj][m][n] = __builtin_amdgcn_mfma_f32_16x16x32_bf16(Bt[n][k], At[m][k], acc[ai][bj][m][n], 0, 0, 0); __builtin_amdgcn_s_setprio(0); } while (0)
#define PG8_WAIT_V(n) asm volatile("s_waitcnt vmcnt(" #n ")" ::: "memory")
#define PG8_WAIT_L(n) asm volatile("s_waitcnt lgkmcnt(" #n ")" ::: "memory")
#define PG8_BAR __builtin_amdgcn_s_barrier()
#define PG8_SCHED __builtin_amdgcn_sched_barrier(0)
    GUnit cur, nxt; int ui = 0;
    if (!S.next(0, cur)) return;
    f32x4 acc[2][2][4][2];
#pragma unroll
    for (int a = 0; a < 2; ++a)
#pragma unroll
        for (int b = 0; b < 2; ++b)
#pragma unroll
            for (int m = 0; m < 4; ++m)
#pragma unroll
                for (int n = 0; n < 2; ++n) acc[a][b][m][n] = (f32x4){0.f, 0.f, 0.f, 0.f};
    bf16x8 At[4][2], B0[2][2], B1[2][2];
    const char* cA = cur.A; const char* cB = cur.B;
    int ldA = cur.lda2, ldB = cur.nt * 128;
    const size_t kstep = 128;
    PG8_STAGE(PG8_SB(0, 0), cB, ldB, Rb0); PG8_STAGE(PG8_SB(0, 1), cB + (size_t)HALF * ldB, ldB, Rb0); PG8_STAGE(PG8_SA(0, 0), cA, ldA, R0); PG8_STAGE(PG8_SA(0, 1), cA + (size_t)HALF * ldA, ldA, R0);
    if (wr == 1) PG8_BAR;
    PG8_WAIT_V(2); PG8_BAR;
    PG8_STAGE(PG8_SB(1, 0), cB + kstep, ldB, Rb0); PG8_STAGE(PG8_SA(1, 0), cA + kstep, ldA, R0); PG8_STAGE(PG8_SB(1, 1), cB + (size_t)HALF * ldB + kstep, ldB, Rb0);
    PG8_WAIT_V(6); PG8_BAR;
    for (;;) {
        const bool has_next = S.next(ui + 1, nxt);
        const char* nA = has_next ? nxt.A : cA; const char* nB = has_next ? nxt.B : cB;
        const int nldA = has_next ? nxt.lda2 : ldA, nldB = has_next ? nxt.nt * 128 : ldB;
        const int nt = cur.nt;
        for (int t = 0; t < nt; t += 2) {
            const bool last = (t == nt - 2);
            if (cur.kind == EP_MERGE && (t == 8 || t == 16)) E.mid(acc, t == 8 ? 0 : 1, tid);
            const char* a1 = cA + (size_t)(t + 1) * kstep;
            const char* a2 = last ? nA : cA + (size_t)(t + 2) * kstep; const char* b2 = last ? nB : cB + (size_t)(t + 2) * kstep;
            const char* a3 = a2 + kstep; const char* b3 = b2 + kstep;
            const int xldA = last ? nldA : ldA, xldB = last ? nldB : ldB;
            PG8_LDB(B0, 0, 0); PG8_LDB(B1, 0, 1); PG8_SCHED; PG8_LDA(At, 0, 0); PG8_STAGE(PG8_SA(1, 1), a1 + (size_t)HALF * ldA, ldA, R0);
            PG8_WAIT_V(8); PG8_WAIT_L(0); PG8_BAR; PG8_MMA(0, 0, At, B0); PG8_MMA(0, 1, At, B1); PG8_BAR; PG8_SCHED;
            PG8_LDA(At, 0, 1); PG8_STAGE(PG8_SB(0, 0), b2, xldB, Rb0); PG8_STAGE(PG8_SB(0, 1), b2 + (size_t)HALF * xldB, xldB, Rb0); PG8_STAGE(PG8_SA(0, 0), a2, xldA, R0);
            PG8_WAIT_V(8); PG8_WAIT_L(0); PG8_BAR; PG8_MMA(1, 0, At, B0); PG8_MMA(1, 1, At, B1); PG8_BAR; PG8_SCHED;
            PG8_LDB(B0, 1, 0); PG8_LDB(B1, 1, 1); PG8_SCHED; PG8_LDA(At, 1, 0); PG8_STAGE(PG8_SA(0, 1), a2 + (size_t)HALF * xldA, xldA, R0);
            PG8_WAIT_V(8); PG8_WAIT_L(0); PG8_BAR; PG8_MMA(0, 0, At, B0); PG8_MMA(0, 1, At, B1); PG8_BAR; PG8_SCHED;
            PG8_LDA(At, 1, 1); PG8_STAGE(PG8_SB(1, 0), b3, xldB, Rb0); PG8_STAGE(PG8_SB(1, 1), b3 + (size_t)HALF * xldB, xldB, Rb0); PG8_STAGE(PG8_SA(1, 0), a3, xldA, R0);
            PG8_WAIT_V(8); PG8_WAIT_L(0); PG8_BAR; PG8_MMA(1, 0, At, B0); PG8_MMA(1, 1, At, B1); PG8_BAR; PG8_SCHED;
        }
        if (wr == 0) PG8_BAR;
        if (!dry) E(acc, cur, wr, wc, fr, fq, tid);
        if (!has_next) break;
#pragma unroll
        for (int a = 0; a < 2; ++a)
#pragma unroll
            for (int b = 0; b < 2; ++b)
#pragma unroll
                for (int m = 0; m < 4; ++m)
#pragma unroll
                    for (int n = 0; n < 2; ++n) acc[a][b][m][n] = (f32x4){0.f, 0.f, 0.f, 0.f};
        cur = nxt; cA = nA; cB = nB; ldA = nldA; ldB = nldB; ++ui;
        if (wr == 1) PG8_BAR;
    }
    PG8_WAIT_V(0);
    PG8_BAR;
}

constexpr int AK_PITCH = 208, AK_BYTES = 64 * AK_PITCH, AV_BYTES = 8192;
constexpr int A_K0 = 0, A_V0 = 4 * AK_BYTES, A_WS = A_V0 + 4 * AV_BYTES, A_OST = A_WS + 2048, A_OP = 144, A_END = A_OST + 8 * 32 * A_OP;
static_assert(A_END <= 147200, "attention lds");
__device__ __forceinline__ float max3f(float a, float b, float c) { return fmaxf(fmaxf(a, b), c); }
__device__ __forceinline__ void attn_unit(LAS char* lds, const bf16_t* Qp, const bf16_t* KVp, const bf16_t* KRp, int ntiles, bf16_t* Yp, bool dry) {
    int tid = threadIdx.x; asm volatile("" : "+v"(tid)); const int lane = tid & 63, r32 = lane & 31, hi = lane >> 5; const int wid = __builtin_amdgcn_readfirstlane(tid >> 6);
    LAS float* wsf = (LAS float*)(lds + A_WS) + wid * 64;
    const int krow = tid >> 3, kc = tid & 7, rrow = tid >> 2, rc = tid & 3;
    const bf16_t* gk = KVp + (size_t)krow * 1024 + kc * 8;
    const bf16_t* gv = gk + 512;
    const bf16_t* gr = KRp + (size_t)rrow * 32 + rc * 8;
    const int lk = krow * AK_PITCH + kc * 16, lr = rrow * AK_PITCH + 128 + rc * 16, lv = (kc >> 2) * 4096 + krow * 64 + (kc & 3) * 16;
    const bool rth = tid < 256;
    u32x4 skA, svA, srA = {0u, 0u, 0u, 0u}, skB, svB, srB = {0u, 0u, 0u, 0u};
#define AT_LOAD(X, t) do { const size_t adv_ = (size_t)(t) * 64; sk##X = *(const u32x4*)(gk + adv_ * 1024); sv##X = *(const u32x4*)(gv + adv_ * 1024); if (rth) sr##X = *(const u32x4*)(gr + adv_ * 32); } while (0)
#define AT_STORE(X, slot) do { *(LAS u32x4*)(lds + A_K0 + (slot) * AK_BYTES + lk) = sk##X; *(LAS u32x4*)(lds + A_V0 + (slot) * AV_BYTES + lv) = sv##X; if (rth) *(LAS u32x4*)(lds + A_K0 + (slot) * AK_BYTES + lr) = sr##X; } while (0)
    AT_LOAD(A, 0); AT_LOAD(B, 1);
    bf16x8 qf[6];
    { const bf16_t* qrow = Qp + (size_t)(wid * 32 + r32) * 768;
#pragma unroll
      for (int s = 0; s < 6; ++s) qf[s] = *(const bf16x8*)(qrow + 16 * s + 8 * hi); }
    AT_STORE(A, 0); AT_STORE(B, 1);
    __syncthreads();
    float mref = 0.f, lsum = 0.f;
    f32x16 o0 = {}, o1 = {};
    const int g16 = (lane >> 4) & 1, q4 = (lane & 15) >> 2, p4 = lane & 3;
    const int vtr = (4 * hi + q4) * 64 + (16 * g16 + 4 * p4) * 2;
#define AT_QK(slot, P0, P1) do { const LAS char* Kb = lds + A_K0 + (slot) * AK_BYTES; \
        _Pragma("unroll") for (int s = 0; s < 6; ++s) { \
            const bf16x8 k0 = *(const LAS bf16x8*)(Kb + r32 * AK_PITCH + (16 * s + 8 * hi) * 2); \
            const bf16x8 k1 = *(const LAS bf16x8*)(Kb + (r32 + 32) * AK_PITCH + (16 * s + 8 * hi) * 2); \
            P0 = __builtin_amdgcn_mfma_f32_32x32x16_bf16(k0, qf[s], P0, 0, 0, 0); P1 = __builtin_amdgcn_mfma_f32_32x32x16_bf16(k1, qf[s], P1, 0, 0, 0); } } while (0)
#define AT_SMPV(slot, first, p0, p1) do { const LAS char* Vb = lds + A_V0 + (slot) * AV_BYTES; \
        float ra = max3f(p0[0], p0[1], p1[0]), rb = max3f(p0[2], p0[3], p1[1]); ra = max3f(ra, p1[2], p1[3]); \
        _Pragma("unroll") for (int r = 4; r < 16; r += 4) { ra = max3f(ra, p0[r], p0[r + 1]); rb = max3f(rb, p0[r + 2], p0[r + 3]); ra = max3f(ra, p1[r], p1[r + 1]); rb = max3f(rb, p1[r + 2], p1[r + 3]); } \
        float rm = fmaxf(ra, rb); rm = fmaxf(rm, __shfl_xor(rm, 32)) - mref; \
        if ((first) || __any(rm > 8.f)) { \
            const float dl = (first) ? rm : fmaxf(rm, 0.f); mref += dl; const float al = fexp2(-dl); lsum *= al; \
            if (!(first)) { if (hi == 0) wsf[r32] = al; \
                asm volatile("s_waitcnt lgkmcnt(0)" ::: "memory"); \
                _Pragma("unroll") for (int k = 0; k < 4; ++k) { const f32x4 a = *(const LAS f32x4*)(wsf + 8 * k + 4 * hi); \
                    _Pragma("unroll") for (int j = 0; j < 4; ++j) { o0[4 * k + j] *= a[j]; o1[4 * k + j] *= a[j]; } } } \
        } \
        _Pragma("unroll") for (int r = 0; r < 16; ++r) { p0[r] = fexp2(p0[r] - mref); p1[r] = fexp2(p1[r] - mref); } \
        { float sa = p0[0] + p1[0], sb = p0[1] + p1[1], sc_ = p0[2] + p1[2], sd = p0[3] + p1[3]; \
          _Pragma("unroll") for (int r = 4; r < 16; r += 4) { sa += p0[r] + p1[r]; sb += p0[r + 1] + p1[r + 1]; sc_ += p0[r + 2] + p1[r + 2]; sd += p0[r + 3] + p1[r + 3]; } \
          lsum += (sa + sb) + (sc_ + sd); } \
        u32x4 pw[4]; \
        pw[0] = (u32x4){cvtpk(p0[0], p0[1]), cvtpk(p0[2], p0[3]), cvtpk(p0[4], p0[5]), cvtpk(p0[6], p0[7])}; \
        pw[1] = (u32x4){cvtpk(p0[8], p0[9]), cvtpk(p0[10], p0[11]), cvtpk(p0[12], p0[13]), cvtpk(p0[14], p0[15])}; \
        pw[2] = (u32x4){cvtpk(p1[0], p1[1]), cvtpk(p1[2], p1[3]), cvtpk(p1[4], p1[5]), cvtpk(p1[6], p1[7])}; \
        pw[3] = (u32x4){cvtpk(p1[8], p1[9]), cvtpk(p1[10], p1[11]), cvtpk(p1[12], p1[13]), cvtpk(p1[14], p1[15])}; \
        _Pragma("unroll") for (int u = 0; u < 4; ++u) { \
            const LAS char* vb = Vb + vtr + u * 16 * 64; \
            const s16x4 a0 = trread(vb), a1 = trread(vb + 8 * 64), b0 = trread(vb + 4096), b1 = trread(vb + 4096 + 8 * 64); \
            o0 = __builtin_amdgcn_mfma_f32_32x32x16_bf16(__builtin_bit_cast(bf16x8, pw[u]), MK8(a0, a1), o0, 0, 0, 0); \
            o1 = __builtin_amdgcn_mfma_f32_32x32x16_bf16(__builtin_bit_cast(bf16x8, pw[u]), MK8(b0, b1), o1, 0, 0, 0); } \
    } while (0)
    for (int t = 0; t < ntiles; t += 2) {
        const int sb0 = (t & 2);
        const bool more = (t + 2 < ntiles);
        f32x16 pa0 = {}, pa1 = {}, pb0 = {}, pb1 = {};
        AT_QK(sb0, pa0, pa1);
        AT_QK(sb0 + 1, pb0, pb1);
        if (t == 0) AT_SMPV(sb0, true, pa0, pa1); else AT_SMPV(sb0, false, pa0, pa1);
        __builtin_amdgcn_sched_barrier(0);
        if (more) { AT_LOAD(A, t + 2); AT_LOAD(B, t + 3); }
        AT_SMPV(sb0 + 1, false, pb0, pb1);
        if (more) { AT_STORE(A, sb0 ^ 2); AT_STORE(B, (sb0 ^ 2) + 1); }
        __syncthreads();
    }
#undef AT_LOAD
#undef AT_STORE
#undef AT_QK
#undef AT_SMPV
    lsum += __shfl_xor(lsum, 32);
    if (hi == 0) wsf[r32] = frcp(lsum);
    asm volatile("s_waitcnt lgkmcnt(0)" ::: "memory");
    LAS char* ost = lds + A_OST + wid * (32 * A_OP);
#pragma unroll
    for (int k = 0; k < 4; ++k) { const f32x4 a = *(const LAS f32x4*)(wsf + 8 * k + 4 * hi);
#pragma unroll
        for (int j = 0; j < 4; ++j) { const int r = 4 * k + j; LAS bf16_t* op = (LAS bf16_t*)(ost + crow(r, hi) * A_OP) + r32;
            op[0] = f2bf(o0[r] * a[j]); op[32] = f2bf(o1[r] * a[j]); } }
    asm volatile("s_waitcnt lgkmcnt(0)" ::: "memory");
#pragma unroll
    for (int i = 0; i < 4; ++i) { const int id = lane + 64 * i, row = id >> 3, ch = id & 7;
        const u32x4 ov = *(const LAS u32x4*)(ost + row * A_OP + ch * 16);
        bf16_t* yp = Yp + (size_t)(wid * 32 + row) * ZP + ch * 8;
        if (!dry) { const u32x4 gv = *(const u32x4*)yp; u32x4 w;
            w.x = cvtpk(bflo(ov.x) * bflo(gv.x), bfhi(ov.x) * bfhi(gv.x)); w.y = cvtpk(bflo(ov.y) * bflo(gv.y), bfhi(ov.y) * bfhi(gv.y));
            w.z = cvtpk(bflo(ov.z) * bflo(gv.z), bfhi(ov.z) * bfhi(gv.z)); w.w = cvtpk(bflo(ov.w) * bflo(gv.w), bfhi(ov.w) * bfhi(gv.w));
            *(u32x4*)yp = w; } }
    __syncthreads();
}

constexpr int GP = 144, GARR = 64 * GP;
constexpr int G_Q = 0, G_K = GARR, G_KD = 2 * GARR, G_V = 3 * GARR, G_AM = 4 * GARR, G_SB = 5 * GARR, G_O = 6 * GARR, G_A16 = 7 * GARR, G_DEC = G_A16 + 2048, G_TOT = G_DEC + 256, G_GROUP = 68096;
static_assert(G_TOT + 512 <= G_GROUP && 2 * G_GROUP <= 147200, "gla lds");
__device__ __forceinline__ void gla_unit(LAS char* lds0, int b, int h, int dvh, bf16_t* Z, bf16_t* OT, const float* afw, const float* afb, const float* abw, const float* abb, bool dry) {
    int tid = threadIdx.x; asm volatile("" : "+v"(tid)); const int lane = tid & 63, r32 = lane & 31, hi = lane >> 5; const int wid = __builtin_amdgcn_readfirstlane(tid >> 6);
    const int dir = wid >> 2, wg = wid & 3, tg = tid & 255;
    LAS char* lds = lds0 + dir * G_GROUP;
    const int g16 = (lane >> 4) & 1, q4 = (lane & 15) >> 2, p4 = lane & 3;
    const int I = wg >> 1, J = wg & 1;
    const float* w2 = dir ? abw : afw; const float* bb = dir ? abb : afb;
    bf16x8 w2b;
    { u32x4 t; t.x = cvtpk(w2[(8 * hi + 0) * 256 + h * 64 + 32 * J + r32], w2[(8 * hi + 1) * 256 + h * 64 + 32 * J + r32]);
      t.y = cvtpk(w2[(8 * hi + 2) * 256 + h * 64 + 32 * J + r32], w2[(8 * hi + 3) * 256 + h * 64 + 32 * J + r32]);
      t.z = cvtpk(w2[(8 * hi + 4) * 256 + h * 64 + 32 * J + r32], w2[(8 * hi + 5) * 256 + h * 64 + 32 * J + r32]);
      t.w = cvtpk(w2[(8 * hi + 6) * 256 + h * 64 + 32 * J + r32], w2[(8 * hi + 7) * 256 + h * 64 + 32 * J + r32]);
      w2b = __builtin_bit_cast(bf16x8, t); }
    const float bias = bb[h * 64 + 32 * J + r32];
    const int zcol_a = dir ? ZAB : ZAF;
    f32x16 S = {};
    for (int i = tg; i < GARR / 4; i += 256) ((LAS unsigned*)(lds + G_SB))[i] = 0u;
    u32x4 pq0, pq1, pk0, pk1, pv0, pv1; u32x2 pa;
    const int lr = tg >> 3, lc = tg & 7, ar = tg >> 2, ac = tg & 3;
#define GLA_CHUNK(s) (dir ? ((s) < 4 ? 3 - (s) : 39 - (s)) : (s))
#define GLA_ROW(rb, i) ((rb) + (dir ? 63 - (i) : (i)))
#define GLA_PREFETCH(s) do { const size_t rb_ = (size_t)b * TOK + 64 * GLA_CHUNK(s); \
        const bf16_t* z0_ = Z + GLA_ROW(rb_, lr) * ZP; const bf16_t* z1_ = Z + GLA_ROW(rb_, lr + 32) * ZP; \
        pq0 = *(const u32x4*)(z0_ + ZGQ + h * 64 + lc * 8); pq1 = *(const u32x4*)(z1_ + ZGQ + h * 64 + lc * 8); \
        pk0 = *(const u32x4*)(z0_ + ZGK + h * 64 + lc * 8); pk1 = *(const u32x4*)(z1_ + ZGK + h * 64 + lc * 8); \
        pv0 = *(const u32x4*)(z0_ + ZGV + h * 128 + dvh * 64 + lc * 8); pv1 = *(const u32x4*)(z1_ + ZGV + h * 128 + dvh * 64 + lc * 8); \
        pa = *(const u32x2*)(Z + GLA_ROW(rb_, ar) * ZP + zcol_a + ac * 4); } while (0)
    GLA_PREFETCH(0);
    for (int s = 0; s < 36; ++s) {
        const int c = GLA_CHUNK(s);
        const size_t rbase = (size_t)b * TOK + 64 * c;
        const int other_step = dir ? c : (c < 4 ? 3 - c : 39 - c);
        const bool second = s > other_step;
        *(LAS u32x4*)(lds + G_Q + lr * GP + lc * 16) = pq0; *(LAS u32x4*)(lds + G_Q + (lr + 32) * GP + lc * 16) = pq1;
        *(LAS u32x4*)(lds + G_K + lr * GP + lc * 16) = pk0; *(LAS u32x4*)(lds + G_K + (lr + 32) * GP + lc * 16) = pk1;
        *(LAS u32x4*)(lds + G_V + lr * GP + lc * 16) = pv0; *(LAS u32x4*)(lds + G_V + (lr + 32) * GP + lc * 16) = pv1;
        *(LAS u32x2*)(lds + G_A16 + ar * 32 + ac * 8) = pa;
        __syncthreads();
        if (s + 1 < 36) GLA_PREFETCH(s + 1);
        u32x4 prv0 = {0u, 0u, 0u, 0u}, prv1 = {0u, 0u, 0u, 0u};
        bf16_t* og0 = OT + GLA_ROW(rbase, lr) * 512 + h * 128 + dvh * 64 + lc * 8;
        bf16_t* og1 = OT + GLA_ROW(rbase, lr + 32) * 512 + h * 128 + dvh * 64 + lc * 8;
        if (second) { prv0 = *(const u32x4*)og0; prv1 = *(const u32x4*)og1; }
        float cs[16];
        {
            f32x16 zc;
#pragma unroll
            for (int r = 0; r < 16; ++r) zc[r] = bias;
            const bf16x8 a = *(const LAS bf16x8*)(lds + G_A16 + (32 * I + r32) * 32 + hi * 16);
            zc = __builtin_amdgcn_mfma_f32_32x32x16_bf16(a, w2b, zc, 0, 0, 0);
#pragma unroll
            for (int r = 0; r < 16; ++r) { const float z = zc[r]; cs[r] = (fminf(z, 0.f) - __logf(1.f + fexp(-fabsf(z)))) * (1.f / 16.f); }
        }
#pragma unroll
        for (int g = 0; g < 4; ++g) { cs[4 * g + 1] += cs[4 * g]; cs[4 * g + 2] += cs[4 * g + 1]; cs[4 * g + 3] += cs[4 * g + 2]; }
        float run = 0.f;
#pragma unroll
        for (int g = 0; g < 4; ++g) {
            const float mine = cs[4 * g + 3]; const float oth = __shfl_xor(mine, 32);
            const float off = run + (hi ? oth : 0.f);
#pragma unroll
            for (int j = 0; j < 4; ++j) cs[4 * g + j] += off;
            run += mine + oth;
        }
        if (hi == 0) ((LAS float*)(lds + G_TOT))[I * 64 + 32 * J + r32] = run;
        asm volatile("s_waitcnt lgkmcnt(0)\n\ts_barrier" ::: "memory");
        const float t0v = ((LAS float*)(lds + G_TOT))[32 * J + r32], t1v = ((LAS float*)(lds + G_TOT))[64 + 32 * J + r32];
        const float pre = I ? t0v : 0.f, tot = t0v + t1v;
        const float etot = fexp(tot);
#pragma unroll
        for (int r = 0; r < 16; ++r) {
            const int ii = 32 * I + crow(r, hi), dd = 32 * J + r32; const float eb = fexp(pre + cs[r]); const float ieb = frcp(eb);
            LAS bf16_t* qp = (LAS bf16_t*)(lds + G_Q) + ii * (GP / 2) + dd; LAS bf16_t* kp = (LAS bf16_t*)(lds + G_K) + ii * (GP / 2) + dd;
            const float qv = bf2f(*qp), kv = bf2f(*kp);
            *qp = f2bf(qv * eb); *kp = f2bf(kv * ieb);
            ((LAS bf16_t*)(lds + G_KD))[ii * (GP / 2) + dd] = f2bf(kv * ieb * etot);
        }
        if (I == 0 && hi == 0) ((LAS float*)(lds + G_DEC))[32 * J + r32] = etot;
        asm volatile("s_waitcnt lgkmcnt(0)\n\ts_barrier" ::: "memory");
        f32x16 oacc = {};
        {
            f32x16 Ac = {};
            if (J <= I) {
#pragma unroll
                for (int k = 0; k < 4; ++k) {
                    const bf16x8 a = *(const LAS bf16x8*)(lds + G_Q + (32 * I + r32) * GP + (16 * k + 8 * hi) * 2);
                    const bf16x8 bq = *(const LAS bf16x8*)(lds + G_K + (32 * J + r32) * GP + (16 * k + 8 * hi) * 2);
                    Ac = __builtin_amdgcn_mfma_f32_32x32x16_bf16(a, bq, Ac, 0, 0, 0);
                }
            }
#pragma unroll
            for (int k = 0; k < 4; ++k) {
                const bf16x8 a = *(const LAS bf16x8*)(lds + G_Q + (32 * I + r32) * GP + (16 * k + 8 * hi) * 2);
                const LAS char* sp = lds + G_SB + (16 * k + 8 * hi + q4) * GP + (32 * J + 16 * g16 + 4 * p4) * 2;
                const s16x4 l0 = trread(sp), l1 = trread(sp + 4 * GP);
                oacc = __builtin_amdgcn_mfma_f32_32x32x16_bf16(a, MK8(l0, l1), oacc, 0, 0, 0);
            }
#pragma unroll
            for (int r = 0; r < 16; ++r) { const int i_ = 32 * I + crow(r, hi), j_ = 32 * J + r32;
                ((LAS bf16_t*)(lds + G_AM))[i_ * (GP / 2) + j_] = f2bf((i_ >= j_) ? Ac[r] : 0.f); }
        }
        asm volatile("s_waitcnt lgkmcnt(0)\n\ts_barrier" ::: "memory");
        {
#pragma unroll
            for (int u = 0; u < 4; ++u) {
                const bf16x8 a = *(const LAS bf16x8*)(lds + G_AM + (32 * I + r32) * GP + (16 * u + 8 * hi) * 2);
                const LAS char* vp = lds + G_V + (16 * u + 8 * hi + q4) * GP + (32 * J + 16 * g16 + 4 * p4) * 2;
                const s16x4 l0 = trread(vp), l1 = trread(vp + 4 * GP);
                oacc = __builtin_amdgcn_mfma_f32_32x32x16_bf16(a, MK8(l0, l1), oacc, 0, 0, 0);
            }
#pragma unroll
            for (int r = 0; r < 16; ++r) ((LAS bf16_t*)(lds + G_O))[(32 * I + crow(r, hi)) * (GP / 2) + 32 * J + r32] = f2bf(oacc[r]);
            const int Dd = I;
#pragma unroll
            for (int k = 0; k < 4; ++k) { const f32x4 dc = *(const LAS f32x4*)(lds + G_DEC + (32 * Dd + 8 * k + 4 * hi) * 4);
#pragma unroll
                for (int j = 0; j < 4; ++j) S[4 * k + j] *= dc[j]; }
#pragma unroll
            for (int u = 0; u < 4; ++u) {
                const LAS char* kp = lds + G_KD + (16 * u + 8 * hi + q4) * GP + (32 * Dd + 16 * g16 + 4 * p4) * 2;
                const LAS char* vp = lds + G_V + (16 * u + 8 * hi + q4) * GP + (32 * J + 16 * g16 + 4 * p4) * 2;
                const s16x4 k0 = trread(kp), k1 = trread(kp + 4 * GP), v0 = trread(vp), v1 = trread(vp + 4 * GP);
                S = __builtin_amdgcn_mfma_f32_32x32x16_bf16(MK8(k0, k1), MK8(v0, v1), S, 0, 0, 0);
            }
        }
        asm volatile("s_waitcnt lgkmcnt(0)\n\ts_barrier" ::: "memory");
#pragma unroll
        for (int r = 0; r < 16; ++r) ((LAS bf16_t*)(lds + G_SB))[(32 * I + crow(r, hi)) * (GP / 2) + 32 * J + r32] = f2bf(S[r]);
        {
            u32x4 o0v = *(const LAS u32x4*)(lds + G_O + lr * GP + lc * 16), o1v = *(const LAS u32x4*)(lds + G_O + (lr + 32) * GP + lc * 16);
            if (second) {
                o0v.x = cvtpk(bflo(o0v.x) + bflo(prv0.x), bfhi(o0v.x) + bfhi(prv0.x)); o0v.y = cvtpk(bflo(o0v.y) + bflo(prv0.y), bfhi(o0v.y) + bfhi(prv0.y));
                o0v.z = cvtpk(bflo(o0v.z) + bflo(prv0.z), bfhi(o0v.z) + bfhi(prv0.z)); o0v.w = cvtpk(bflo(o0v.w) + bflo(prv0.w), bfhi(o0v.w) + bfhi(prv0.w));
                o1v.x = cvtpk(bflo(o1v.x) + bflo(prv1.x), bfhi(o1v.x) + bfhi(prv1.x)); o1v.y = cvtpk(bflo(o1v.y) + bflo(prv1.y), bfhi(o1v.y) + bfhi(prv1.y));
                o1v.z = cvtpk(bflo(o1v.z) + bflo(prv1.z), bfhi(o1v.z) + bfhi(prv1.z)); o1v.w = cvtpk(bflo(o1v.w) + bflo(prv1.w), bfhi(o1v.w) + bfhi(prv1.w));
            }
            if (!dry) { *(u32x4*)og0 = o0v; *(u32x4*)og1 = o1v; }
        }
    }
    __syncthreads();
#undef GLA_CHUNK
#undef GLA_ROW
#undef GLA_PREFETCH
}

constexpr int PP = 272;
__device__ __forceinline__ void pool_unit(LAS char* lds, int pm, int g, bf16_t* Z, const bf16_t* Wt  , const float* pscale, bool dry) {
    int tid = threadIdx.x; asm volatile("" : "+v"(tid)); const int lane = tid & 63, r32 = lane & 31, hi = lane >> 5; const int wid = __builtin_amdgcn_readfirstlane(tid >> 6);
    const int col = tid & 127, rq = tid >> 7;
    const int half = 1 << g;
    const int tiw = pm % 9; const int L = (tiw == 0) ? CTXL : SEQ; const int t0 = (tiw == 0) ? 0 : (tiw - 1) * 256;
    const bf16_t* ub = Z + (size_t)(pm * 256 - t0) * ZP + ZPX + g * 128;
    LAS char* U = lds + 256 * PP;
    {
        u32x4 uv[9];
#pragma unroll
        for (int k = 0; k < 9; ++k) { const int i = tid + 512 * k; const int j = i >> 4, ch = i & 15; const int t = t0 - 8 + j;
            uv[k] = (u32x4){0u, 0u, 0u, 0u}; if (i < 272 * 16 && t >= 0 && t < L) uv[k] = *(const u32x4*)(ub + (size_t)t * ZP + ch * 8); }
#pragma unroll
        for (int k = 0; k < 9; ++k) { const int i = tid + 512 * k; const int j = i >> 4, ch = i & 15;
            if (i < 272 * 16) *(LAS u32x4*)(U + j * PP + ch * 16) = uv[k]; }
    }
    __syncthreads();
    {
        const int cg = tid & 31, rsg = tid >> 5;
        const LAS char* uc = U + cg * 8;
        const int ts = t0 + rsg * 16;
        int lo = ts - half; if (lo < 0) lo = 0; int hiw = ts + half; if (hiw > L) hiw = L;
        float s0 = 0.f, s1 = 0.f, s2 = 0.f, s3 = 0.f;
        for (int t = lo; t < hiw; ++t) { const u32x2 v = *(const LAS u32x2*)(uc + (t - t0 + 8) * PP); s0 += bflo(v.x); s1 += bfhi(v.x); s2 += bflo(v.y); s3 += bfhi(v.y); }
#pragma unroll 4
        for (int i = 0; i < 16; ++i) {
            const int t = ts + i;
            int l2 = t - half; if (l2 < 0) l2 = 0; int h2 = t + half; if (h2 > L) h2 = L;
            const u32x2 ut = *(const LAS u32x2*)(uc + (t - t0 + 8) * PP);
            const float rc = frcp((float)(h2 - l2));
            u32x2 w; w.x = cvtpk(s0 * rc - bflo(ut.x), s1 * rc - bfhi(ut.x)); w.y = cvtpk(s2 * rc - bflo(ut.y), s3 * rc - bfhi(ut.y));
            *(LAS u32x2*)(lds + (rsg * 16 + i) * PP + cg * 8) = w;
            if (t + half < L) { const u32x2 v = *(const LAS u32x2*)(uc + (t + half - t0 + 8) * PP); s0 += bflo(v.x); s1 += bfhi(v.x); s2 += bflo(v.y); s3 += bfhi(v.y); }
            if (t - half >= 0) { const u32x2 v = *(const LAS u32x2*)(uc + (t - half - t0 + 8) * PP); s0 -= bflo(v.x); s1 -= bfhi(v.x); s2 -= bflo(v.y); s3 -= bfhi(v.y); }
        }
    }
    __syncthreads();
    f32x16 acc[4] = {};
#pragma unroll
    for (int s = 0; s < 8; ++s) {
        const bf16x8 a = *(const LAS bf16x8*)(lds + (32 * wid + r32) * PP + (16 * s + 8 * hi) * 2);
#pragma unroll
        for (int n = 0; n < 4; ++n) {
            const bf16x8 bw = *(const bf16x8*)(Wt + (size_t)(32 * n + r32) * 128 + 16 * s + 8 * hi);
            acc[n] = __builtin_amdgcn_mfma_f32_32x32x16_bf16(a, bw, acc[n], 0, 0, 0);
        }
    }
#pragma unroll
    for (int n = 0; n < 4; ++n) { const float sc = pscale[g * 128 + 32 * n + r32];
#pragma unroll
        for (int r = 0; r < 16; ++r) ((LAS bf16_t*)lds)[(32 * wid + crow(r, hi)) * (PP / 2) + 32 * n + r32] = f2bf(acc[n][r] * sc); }
    asm volatile("s_waitcnt lgkmcnt(0)" ::: "memory");
#pragma unroll
    for (int i = 0; i < 8; ++i) { const int id = lane + 64 * i, row = id >> 4, ch = id & 15;
        const u32x4 ov = *(const LAS u32x4*)(lds + (32 * wid + row) * PP + ch * 16);
        bf16_t* yp = Z + (size_t)(pm * 256 + 32 * wid + row) * ZP + ZYP + g * 128 + ch * 8;
        if (!dry) { const u32x4 gv = *(const u32x4*)yp; u32x4 w;
            w.x = cvtpk(bflo(ov.x) * bflo(gv.x), bfhi(ov.x) * bfhi(gv.x)); w.y = cvtpk(bflo(ov.y) * bflo(gv.y), bfhi(ov.y) * bfhi(gv.y));
            w.z = cvtpk(bflo(ov.z) * bflo(gv.z), bfhi(ov.z) * bfhi(gv.z)); w.w = cvtpk(bflo(ov.w) * bflo(gv.w), bfhi(ov.w) * bfhi(gv.w));
            *(u32x4*)yp = w; } }
    __syncthreads();
}

__device__ __forceinline__ void prep_item(const Params& p, int l, int mat, int n, int kc, unsigned char* wl) {
    const int k0 = kc * 8; float v[8];
    bf16_t* dst;
    if (mat == 0) {
        dst = (bf16_t*)(wl + W_IN) + (size_t)n * 1024 + k0;
        int col = -1; float sg = 1.f;
        if (n < 256) col = C_MQ + n;
        else if (n < 512) { const int cc = n - 256;
            if (cc < 128) col = C_MKV + cc;
            else if (cc < 192) { const int c2 = cc - 128, g = c2 >> 3, nn = (c2 >> 2) & 1, j = c2 & 3, i = 4 * g + j;
                if (nn == 0) col = C_MKR + i; else { const int i16 = i & 15, base = i & 16; if (i16 < 8) { col = C_MKR + base + i16 + 8; sg = -1.f; } else col = C_MKR + base + i16 - 8; } }
            else if (cc < 208) col = C_AF + cc - 192;
            else if (cc < 224) col = C_AB + cc - 208; }
        else if (n < 1024) col = C_PX + n - 512;
        else if (n < 1280) col = C_GQ + n - 1024;
        else if (n < 1536) col = C_GK + n - 1280;
        else if (n < 2048) col = C_GV + n - 1536;
        else if (n < 2560) col = C_MG + n - 2048;
        else if (n < 3072) col = C_PG + n - 2560;
        else col = C_GG + n - 3072;
        const float* src = p.w_in + (size_t)l * D * DIN;
#pragma unroll
        for (int i = 0; i < 8; ++i) v[i] = (col >= 0) ? sg * src[(size_t)(k0 + i) * DIN + col] : 0.f;
    } else if (mat == 1) {
        dst = (bf16_t*)(wl + W_M) + (size_t)n * 1024 + k0;
        const float* src = p.w_in + (size_t)l * D * DIN + C_MRG + n;
#pragma unroll
        for (int i = 0; i < 8; ++i) v[i] = src[(size_t)(k0 + i) * DIN];
    } else if (mat == 2) {
        dst = (bf16_t*)(wl + W_UQ) + (size_t)n * 256 + k0;
        const int head = n >> 7, cc = n & 127; int col; float sg = 1.f;
        if (cc < 64) col = head * 96 + cc;
        else { const int c2 = cc - 64, g = c2 >> 3, nn = (c2 >> 2) & 1, j = c2 & 3, i = 4 * g + j;
            if (nn == 0) col = head * 96 + 64 + i; else { const int i16 = i & 15, base = i & 16; if (i16 < 8) { col = head * 96 + 64 + base + i16 + 8; sg = -1.f; } else col = head * 96 + 64 + base + i16 - 8; } }
        const float* src = p.mla_w_uq + (size_t)l * 256 * 768 + col; const float* gn = p.mla_q_norm + l * 256;
#pragma unroll
        for (int i = 0; i < 8; ++i) v[i] = sg * gn[k0 + i] * src[(size_t)(k0 + i) * 768];
    } else if (mat == 3) {
        dst = (bf16_t*)(wl + W_UKV) + (size_t)n * 256 + k0;
        const int col = (n < 512) ? ((n >> 6) * 128 + (n & 63)) : (((n - 512) >> 6) * 128 + 64 + (n & 63));
        const float* src = p.mla_w_ukv + (size_t)l * 128 * 1024 + col; const float* gn = p.mla_kv_norm + l * 128;
#pragma unroll
        for (int i = 0; i < 8; ++i) v[i] = (k0 < 128) ? gn[k0 + i] * src[(size_t)(k0 + i) * 1024] : 0.f;
    } else if (mat == 4) {
        dst = (bf16_t*)(wl + W_BR) + (size_t)n * 1536 + k0;
        const int br = k0 >> 9, kk = k0 & 511;
        const float* src = (br == 0 ? p.w_bm : (br == 1 ? p.w_bp : p.w_bg)) + (size_t)l * 512 * 1024 + n;
#pragma unroll
        for (int i = 0; i < 8; ++i) v[i] = src[(size_t)(kk + i) * 1024];
    } else if (mat == 5) {
        dst = (bf16_t*)(wl + W_OUT) + (size_t)n * 1024 + k0;
        const float* src = p.w_out + (size_t)l * 1024 * 1024 + n;
#pragma unroll
        for (int i = 0; i < 8; ++i) v[i] = src[(size_t)(k0 + i) * 1024];
    } else {
        dst = (bf16_t*)(wl + W_POOL) + (size_t)n * 128 + k0;
        const int g = n >> 7, o = n & 127;
        const float* src = p.pool_w + (size_t)l * 4 * 128 * 128 + (size_t)g * 128 * 128 + o;
#pragma unroll
        for (int i = 0; i < 8; ++i) v[i] = src[(size_t)(k0 + i) * 128];
    }
    u32x4 o; o.x = cvtpk(v[0], v[1]); o.y = cvtpk(v[2], v[3]); o.z = cvtpk(v[4], v[5]); o.w = cvtpk(v[6], v[7]);
    *(u32x4*)dst = o;
}

__device__ __forceinline__ void modnorm_row(const float* xr, const float* pre_g, const float* modrow, bf16_t* hrow, int l32) {
    f32x4 v[8]; float s = 0.f;
#pragma unroll
    for (int j = 0; j < 4; ++j) { v[2 * j] = *(const f32x4*)(xr + 8 * l32 + 256 * j); v[2 * j + 1] = *(const f32x4*)(xr + 8 * l32 + 256 * j + 4); }
#pragma unroll
    for (int j = 0; j < 8; ++j) s += v[j][0] * v[j][0] + v[j][1] * v[j][1] + v[j][2] * v[j][2] + v[j][3] * v[j][3];
#pragma unroll
    for (int o = 1; o < 32; o <<= 1) s += __shfl_xor(s, o);
    const float rs = __builtin_amdgcn_rsqf(s * (1.f / D) + EPS);
#pragma unroll
    for (int j = 0; j < 4; ++j) { float o[8];
#pragma unroll
        for (int q = 0; q < 2; ++q) { const int c = 8 * l32 + 256 * j + 4 * q;
            const f32x4 g = *(const f32x4*)(pre_g + c), sh = *(const f32x4*)(modrow + c), sc = *(const f32x4*)(modrow + D + c);
#pragma unroll
            for (int e = 0; e < 4; ++e) o[4 * q + e] = v[2 * j + q][e] * rs * g[e] * (1.f + sc[e]) + sh[e]; }
        u32x4 pk; pk.x = cvtpk(o[0], o[1]); pk.y = cvtpk(o[2], o[3]); pk.z = cvtpk(o[4], o[5]); pk.w = cvtpk(o[6], o[7]);
        *(u32x4*)(hrow + 8 * l32 + 256 * j) = pk; }
}

__global__ void __launch_bounds__(512, 2) fwd_kernel(Params p) {
    extern __shared__ __attribute__((aligned(16))) unsigned char lds_raw[];
    LAS unsigned char* lds = (LAS unsigned char*)lds_raw;
    cg::grid_group grid = cg::this_grid();
    const int wid = __builtin_amdgcn_readfirstlane(threadIdx.x >> 6);
    const int G = gridDim.x, bid = blockIdx.x;
    const int vcu = (G % 8 == 0) ? (bid % 8) * (G / 8) + bid / 8 : bid;
    const int gw = bid * 8 + wid, NGW = G * 8;
    unsigned char* ws = p.ws;
    bf16_t* Z = (bf16_t*)(ws + OFF_Z); bf16_t* H = (bf16_t*)(ws + OFF_H); bf16_t* Qb = (bf16_t*)(ws + OFF_Q); bf16_t* KVb = (bf16_t*)(ws + OFF_KV);
    bf16_t* OT = (bf16_t*)(ws + OFF_OT); bf16_t* KR = (bf16_t*)(ws + OFF_KR);
    float* ssq_q = (float*)(ws + OFF_SSQQ); float* ssq_kv = (float*)(ws + OFF_SSQKV); float* modb = (float*)(ws + OFF_MOD); f32x2* tab = (f32x2*)(ws + OFF_TAB);
    const int lo = p.ph_lo, hi_ph = p.ph_hi; const bool dryflag = (p.ph_lo == 0);
    unsigned* barw = (unsigned*)(ws + OFF_BAR);
    XcdBarrier xbar; xbar.bar = barw; xbar.x = 0; xbar.st = (volatile LAS unsigned*)(lds + 147200);
    if (threadIdx.x < 2) ((volatile LAS unsigned*)(lds + 147200))[threadIdx.x] = 0u;
    if (bid == 0) for (int i = threadIdx.x; i < XCD_BAR_WORDS; i += 512) barw[i] = 0u;
    int ph = 0;
#define PHASE_BEGIN if (ph >= lo && ph < hi_ph) { int tid = threadIdx.x; asm volatile("" : "+v"(tid)); const int lane = tid & 63; (void)lane;
#define PHASE_END } ++ph; if (ph > lo && ph < hi_ph) { if (ph == 1) { grid.sync(); xbar = xcd_barrier_post(barw, (volatile LAS unsigned*)(lds + 147200)); } else { xcd_barrier(xbar); if (DUP == 12) { xcd_barrier(xbar); xcd_barrier(xbar); xcd_barrier(xbar); xcd_barrier(xbar); } } }

    PHASE_BEGIN
    for (int rep = (DUP == 10 ? 0 : 1); rep < 2; ++rep) {
        const long gt = (long)bid * 512 + tid, NT = (long)G * 512;
        for (int l = 0; l < 2; ++l) {
            unsigned char* wl = ws + OFF_W + (size_t)l * W_LAYER;
            for (long it = gt; it < 3584L * 128; it += NT) prep_item(p, l, 0, (int)(it % 3584), (int)(it / 3584), wl);
            for (long it = gt; it < 3072L * 128; it += NT) prep_item(p, l, 1, (int)(it % 3072), (int)(it / 3072), wl);
            for (long it = gt; it < 1024L * 32; it += NT) prep_item(p, l, 2, (int)(it % 1024), (int)(it / 1024), wl);
            for (long it = gt; it < 1024L * 32; it += NT) prep_item(p, l, 3, (int)(it % 1024), (int)(it / 1024), wl);
            for (long it = gt; it < 1024L * 192; it += NT) prep_item(p, l, 4, (int)(it % 1024), (int)(it / 1024), wl);
            for (long it = gt; it < 1024L * 128; it += NT) prep_item(p, l, 5, (int)(it % 1024), (int)(it / 1024), wl);
            for (long it = gt; it < 512L * 16; it += NT) prep_item(p, l, 6, (int)(it % 512), (int)(it / 512), wl);
        }
        if (gt < 512) { const int pos = (int)gt >> 3, f = (int)gt & 7; const float inv = exp2f(-(float)f * (13.287712379549449f / 8.f));
            const float rev = (float)pos * inv * 0.15915494309189535f; const float fr_ = rev - floorf(rev);
            f32x2 e; e.x = __builtin_amdgcn_cosf(fr_); e.y = __builtin_amdgcn_sinf(fr_); tab[gt] = e; }
        for (long i = gt; i < M; i += NT) { ssq_q[i] = 0.f; ssq_kv[i] = 0.f; }
        LAS float* sc = (LAS float*)lds;
        for (int i = tid; i < 33 * 1024; i += 512) { const int bb = i >> 10, k = i & 1023; const float cv = (bb < 32) ? p.c[bb * 1024 + k] : p.c_ctx[k]; sc[i] = cv / (1.f + __expf(-cv)); }
        __syncthreads();
        for (int u = bid; u < 192; u += G) {
            const int l = u / 96, cgp = u % 96; const int colq = tid & 31, kg = tid >> 5;
            float a[33];
#pragma unroll
            for (int bb = 0; bb < 33; ++bb) a[bb] = 0.f;
            const float* wp = p.mod_w + (size_t)l * 1024 * 3072 + cgp * 32 + colq;
            for (int k0 = kg * 64; k0 < kg * 64 + 64; k0 += 8) { float w8[8];
#pragma unroll
                for (int q = 0; q < 8; ++q) w8[q] = wp[(size_t)(k0 + q) * 3072];
#pragma unroll
                for (int q = 0; q < 8; ++q)
#pragma unroll
                    for (int bb = 0; bb < 33; ++bb) a[bb] += sc[bb * 1024 + k0 + q] * w8[q]; }
            LAS float* red = (LAS float*)(lds + 135168);
            for (int i = tid; i < 33 * 32; i += 512) red[i] = 0.f;
            __syncthreads();
#pragma unroll
            for (int bb = 0; bb < 33; ++bb) atomicAdd((float*)(red + bb * 32 + colq), a[bb]);
            __syncthreads();
            for (int i = tid; i < 33 * 32; i += 512) { const int bb = i >> 5, cq = i & 31; modb[((size_t)l * 33 + bb) * 3072 + cgp * 32 + cq] = red[i] + p.mod_b[l * 3072 + cgp * 32 + cq]; }
            __syncthreads();
        }
    }
    PHASE_END

    PHASE_BEGIN
    for (int rep = (DUP == 9 ? 0 : 1); rep < 2; ++rep)
    for (int r0 = 2 * gw; r0 < M; r0 += 2 * NGW) { const int r = r0 + (lane >> 5);
        const int b = r / TOK, tok = r % TOK;
        const float* xr = (tok < CTXL) ? p.ctx + ((size_t)b * CTXL + tok) * D : p.x + ((size_t)b * SEQ + tok - CTXL) * D;
        modnorm_row(xr, p.pre_norm, modb + (size_t)((tok < CTXL) ? 32 : b) * 3072, H + (size_t)r * D, lane & 31);
    }
    PHASE_END

    for (int l = 0; l < 2; ++l) {
        unsigned char* wl = ws + OFF_W + (size_t)l * W_LAYER;
        GEpi E; E.Z = Z; E.KR = KR; E.ssq_q = ssq_q; E.ssq_kv = ssq_kv; E.Qb = Qb; E.KVb = KVb; E.gscr = ws + OFF_Q + (size_t)bid * GSCR_PER_WG; E.tab = tab;
        GSched S; S.G = G; S.c = bid; S.Z = (const char*)Z; S.H = (const char*)H; S.W = (const char*)wl;

        PHASE_BEGIN
        S.mode = 0; S.latent_only = (l == 1);
        if (DUP == 1) gemm_phase(lds, S, E, dryflag);
        gemm_phase(lds, S, E, false);
        PHASE_END

        PHASE_BEGIN
        for (int rep = (DUP == 2 ? 0 : 1); rep < 2; ++rep)
        for (int u = vcu; u < 256; u += G) {
            const int b = u >> 3, h = (u >> 1) & 3, dvh = u & 1;
            gla_unit((LAS char*)lds, b, h, dvh, Z, OT, p.af_w2 + l * 16 * 256, p.af_b + l * 256, p.ab_w2 + l * 16 * 256, p.ab_b + l * 256, rep == 0 && dryflag);
        }
        __syncthreads();
        S.mode = 1; S.latent_only = (l == 1);
        if (DUP == 3) gemm_phase(lds, S, E, dryflag);
        gemm_phase(lds, S, E, false);
        for (int rep = (DUP == 4 ? 0 : 1); rep < 2; ++rep)
        for (int u = vcu; u < 288 * 4; u += G) { const int pm = u >> 2, g = u & 3;
            if (l == 1 && pm % 9 == 0) continue;
            pool_unit((LAS char*)lds, pm, g, Z, (const bf16_t*)(wl + W_POOL) + (size_t)g * 128 * 128, p.pool_scale + l * 512, rep == 0 && dryflag); }
        PHASE_END

        PHASE_BEGIN
        for (int rep = (DUP == 11 ? 0 : 1); rep < 2; ++rep)
        for (int r0 = 4 * gw; r0 < M; r0 += 4 * NGW) {
            if (l == 1 && (r0 % TOK) < CTXL) continue;
            const int r = r0 + (lane >> 4), l16 = lane & 15;
            u32x4 ov[4], gv[4];
#pragma unroll
            for (int hh = 0; hh < 4; ++hh) { ov[hh] = *(const u32x4*)(OT + (size_t)r * 512 + hh * 128 + 8 * l16); gv[hh] = *(const u32x4*)(Z + (size_t)r * ZP + ZYG + hh * 128 + 8 * l16); }
            const f32x4 gn0 = *(const f32x4*)(p.gla_norm + l * 128 + 8 * l16), gn1 = *(const f32x4*)(p.gla_norm + l * 128 + 8 * l16 + 4);
#pragma unroll
            for (int hh = 0; hh < 4; ++hh) {
                float o[8] = {bflo(ov[hh].x), bfhi(ov[hh].x), bflo(ov[hh].y), bfhi(ov[hh].y), bflo(ov[hh].z), bfhi(ov[hh].z), bflo(ov[hh].w), bfhi(ov[hh].w)};
                float s = 0.f;
#pragma unroll
                for (int j = 0; j < 8; ++j) s += o[j] * o[j];
                s += __shfl_xor(s, 1); s += __shfl_xor(s, 2); s += __shfl_xor(s, 4); s += __shfl_xor(s, 8);
                const float rs = __builtin_amdgcn_rsqf(s * (1.f / 128.f) + EPS);
                const float gt[8] = {bflo(gv[hh].x), bfhi(gv[hh].x), bflo(gv[hh].y), bfhi(gv[hh].y), bflo(gv[hh].z), bfhi(gv[hh].z), bflo(gv[hh].w), bfhi(gv[hh].w)};
                u32x4 ow; ow.x = cvtpk(o[0] * rs * gn0[0] * gt[0], o[1] * rs * gn0[1] * gt[1]); ow.y = cvtpk(o[2] * rs * gn0[2] * gt[2], o[3] * rs * gn0[3] * gt[3]);
                ow.z = cvtpk(o[4] * rs * gn1[0] * gt[4], o[5] * rs * gn1[1] * gt[5]); ow.w = cvtpk(o[6] * rs * gn1[2] * gt[6], o[7] * rs * gn1[3] * gt[7]);
                if (!(rep == 0 && dryflag)) *(u32x4*)(Z + (size_t)r * ZP + ZYG + hh * 128 + 8 * l16) = ow;
            }
        }
        __syncthreads();
        {
            const int nlat = 2048, nctx = (l == 0) ? 256 : 0;
            for (int rep = (DUP == 5 ? 0 : 1); rep < 2; ++rep)
            for (int u = vcu; u < nlat + nctx; u += G) { const bool dry = (rep == 0) && dryflag;
                if (u < nlat) { const int bh = u >> 3, qb = u & 7, b = bh >> 3, h = bh & 7; const size_t q0 = (size_t)b * TOK + CTXL + qb * 256, k0 = (size_t)b * TOK;
                    attn_unit((LAS char*)lds, Qb + q0 * 768 + h * 96, KVb + k0 * 1024 + h * 64, KR + k0 * 32, 36, Z + q0 * ZP + ZYM + h * 64, dry); }
                else { const int bh = u - nlat, b = bh >> 3, h = bh & 7; const size_t q0 = (size_t)b * TOK;
                    attn_unit((LAS char*)lds, Qb + q0 * 768 + h * 96, KVb + q0 * 1024 + h * 64, KR + q0 * 32, 4, Z + q0 * ZP + ZYM + h * 64, dry); }
            }
        }
        PHASE_END

        PHASE_BEGIN
        S.mode = 2; S.latent_only = (l == 1);
        if (DUP == 6) gemm_phase(lds, S, E, dryflag);
        if (DUP == 13) gemm_phase(lds, S, E, !dryflag);
        gemm_phase(lds, S, E, false);
        PHASE_END

        PHASE_BEGIN
        S.mode = 3; S.latent_only = (l == 1);
        if (DUP == 7) gemm_phase(lds, S, E, dryflag);
        gemm_phase(lds, S, E, false);
        PHASE_END

        PHASE_BEGIN
        for (int rep = (DUP == 8 ? 0 : 1); rep < 2; ++rep)
        for (int r0 = 2 * gw; r0 < M; r0 += 2 * NGW) { const bool dry = (rep == 0) && dryflag;
            const int l32 = lane & 31; const int r = r0 + (lane >> 5);
            const int b = r / TOK, tok = r % TOK; const bool isctx = tok < CTXL;
            if (l == 1 && (r0 % TOK) < CTXL) continue;
            const bf16_t* orow = Z + (size_t)r * ZP + 1024;
            const float* xr = (l == 0) ? (isctx ? p.ctx + ((size_t)b * CTXL + tok) * D : p.x + ((size_t)b * SEQ + tok - CTXL) * D) : p.out + ((size_t)b * SEQ + tok - CTXL) * D;
            const float* mrow = modb + ((size_t)l * 33 + (isctx ? 32 : b)) * 3072;
            u32x4 t4[4]; f32x4 xv[8];
#pragma unroll
            for (int j = 0; j < 4; ++j) { t4[j] = *(const u32x4*)(orow + 8 * l32 + 256 * j); xv[2 * j] = *(const f32x4*)(xr + 8 * l32 + 256 * j); xv[2 * j + 1] = *(const f32x4*)(xr + 8 * l32 + 256 * j + 4); }
            float ov[32]; float s = 0.f;
#pragma unroll
            for (int j = 0; j < 4; ++j) {
                ov[8 * j + 0] = bflo(t4[j].x); ov[8 * j + 1] = bfhi(t4[j].x); ov[8 * j + 2] = bflo(t4[j].y); ov[8 * j + 3] = bfhi(t4[j].y); ov[8 * j + 4] = bflo(t4[j].z); ov[8 * j + 5] = bfhi(t4[j].z); ov[8 * j + 6] = bflo(t4[j].w); ov[8 * j + 7] = bfhi(t4[j].w); }
#pragma unroll
            for (int j = 0; j < 32; ++j) s += ov[j] * ov[j];
#pragma unroll
            for (int o = 1; o < 32; o <<= 1) s += __shfl_xor(s, o);
            const float rs = __builtin_amdgcn_rsqf(s * (1.f / D) + EPS);
            float s2 = 0.f;
#pragma unroll
            for (int j = 0; j < 4; ++j)
#pragma unroll
                for (int q = 0; q < 2; ++q) { const int c = 8 * l32 + 256 * j + 4 * q;
                    const f32x4 pg = *(const f32x4*)(p.post_norm + l * D + c), gt = *(const f32x4*)(mrow + 2 * D + c);
#pragma unroll
                    for (int e = 0; e < 4; ++e) { const float v = xv[2 * j + q][e] + gt[e] * ov[8 * j + 4 * q + e] * rs * pg[e]; ov[8 * j + 4 * q + e] = v; s2 += v * v; } }
            if (!isctx && !dry) { float* orw = p.out + ((size_t)b * SEQ + tok - CTXL) * D;
#pragma unroll
                for (int j = 0; j < 4; ++j)
#pragma unroll
                    for (int q = 0; q < 2; ++q) *(f32x4*)(orw + 8 * l32 + 256 * j + 4 * q) = (f32x4){ov[8 * j + 4 * q], ov[8 * j + 4 * q + 1], ov[8 * j + 4 * q + 2], ov[8 * j + 4 * q + 3]}; }
            if (l == 0) {
#pragma unroll
                for (int o = 1; o < 32; o <<= 1) s2 += __shfl_xor(s2, o);
                if (!dry) {
                const float rs2 = __builtin_amdgcn_rsqf(s2 * (1.f / D) + EPS);
                const float* m1 = modb + ((size_t)33 + (isctx ? 32 : b)) * 3072;
#pragma unroll
                for (int j = 0; j < 4; ++j) { float hv[8];
#pragma unroll
                    for (int q = 0; q < 2; ++q) { const int c = 8 * l32 + 256 * j + 4 * q;
                        const f32x4 g = *(const f32x4*)(p.pre_norm + D + c), sh = *(const f32x4*)(m1 + c), scl = *(const f32x4*)(m1 + D + c);
#pragma unroll
                        for (int e = 0; e < 4; ++e) hv[4 * q + e] = ov[8 * j + 4 * q + e] * rs2 * g[e] * (1.f + scl[e]) + sh[e]; }
                    u32x4 hw; hw.x = cvtpk(hv[0], hv[1]); hw.y = cvtpk(hv[2], hv[3]); hw.z = cvtpk(hv[4], hv[5]); hw.w = cvtpk(hv[6], hv[7]);
                    *(u32x4*)(H + (size_t)r * D + 8 * l32 + 256 * j) = hw; }
                if (l32 == 0) { ssq_q[r] = 0.f; ssq_kv[r] = 0.f; }
                }
            }
        }
        PHASE_END
    }
}

extern "C" void kernel_launch(void* const* d_in, const int* in_sizes, int n_in, void* d_out, int out_size, void* d_ws, size_t ws_size, hipStream_t stream) {
    static int grid = 0;
    if (grid == 0) {
        if (n_in != 24 || ws_size < WS_END) { fprintf(stderr, "kernel_launch: bad inputs n_in=%d ws=%zu need %zu\n", n_in, ws_size, (size_t)WS_END); grid = -1; return; }
        int dev = 0, cus = 0, per_cu = 0;
        hipGetDevice(&dev); hipDeviceGetAttribute(&cus, hipDeviceAttributeMultiprocessorCount, dev);
        hipFuncSetAttribute((const void*)fwd_kernel, hipFuncAttributeMaxDynamicSharedMemorySize, LDS_BYTES);
        hipOccupancyMaxActiveBlocksPerMultiprocessor(&per_cu, (const void*)fwd_kernel, 512, LDS_BYTES);
        if (per_cu < 1) { fprintf(stderr, "kernel_launch: occupancy query returned %d\n", per_cu); per_cu = 1; }
        (void)hipGetLastError();
        grid = cus < 256 ? cus : 256;
    }
    if (grid < 0) return;
    Params p{};
    const float** f = (const float**)&p;
    for (int i = 0; i < 24; ++i) f[i] = (const float*)d_in[i];
    p.out = (float*)d_out; p.ws = (unsigned char*)d_ws; p.ph_lo = 0; p.ph_hi = 1000;
    void* args[] = {&p};
    hipError_t e = hipLaunchCooperativeKernel((const void*)fwd_kernel, dim3(grid), dim3(512), args, LDS_BYTES, stream);
    if (e != hipSuccess) fprintf(stderr, "cooperative launch failed: %s (grid %d)\n", hipGetErrorString(e), grid);
}
```

```cpp
#include <hip/hip_runtime.h>
#include <hip/hip_cooperative_groups.h>
#include <cstdio>
#include <cstdint>
namespace cg = cooperative_groups;

#define LAS __attribute__((address_space(3)))
typedef unsigned short bf16_t;
typedef short bf16x8 __attribute__((ext_vector_type(8)));
typedef short s16x4 __attribute__((ext_vector_type(4)));
typedef float f32x4 __attribute__((ext_vector_type(4)));
typedef float f32x2 __attribute__((ext_vector_type(2)));
typedef float f32x16 __attribute__((ext_vector_type(16)));
typedef unsigned u32x4 __attribute__((ext_vector_type(4)));
typedef unsigned u32x2 __attribute__((ext_vector_type(2)));
typedef __bf16 bf16x2_t __attribute__((ext_vector_type(2)));

constexpr int NB = 32, SEQ = 2048, CTXL = 256, TOK = 2304, M = NB * TOK, D = 1024, DIN = 6592, ZP = 3584;
constexpr int ZQ = 0, ZKV = 256, ZPX = 512, ZGQ = 1024, ZGK = 1280, ZGV = 1536, ZYM = 2048, ZYP = 2560, ZYG = 3072;
constexpr int ZAF = ZKV + 192, ZAB = ZKV + 208;
constexpr float EPS = 1e-6f;
constexpr float QSCALE = 0.10206207261596577f * 1.4426950408889634f;
constexpr int C_MQ = 0, C_MKV = 256, C_MKR = 384, C_MG = 416, C_PX = 928, C_PG = 1440, C_GQ = 1952, C_GK = 2208, C_GV = 2464, C_AF = 2976, C_AB = 2992, C_GG = 3008, C_MRG = 3520;

constexpr size_t SZ_Z = (size_t)M * ZP * 2, SZ_H = (size_t)M * D * 2, SZ_Q = (size_t)M * 768 * 2, SZ_KV = (size_t)M * 1024 * 2, SZ_OT = (size_t)M * 512 * 2, SZ_KR = (size_t)M * 32 * 2;
constexpr size_t OFF_Z = 0, OFF_H = OFF_Z + SZ_Z, OFF_Q = OFF_H + SZ_H, OFF_KV = OFF_Q + SZ_Q, OFF_OT = OFF_KV + SZ_KV, OFF_KR = OFF_OT + SZ_OT, OFF_W = OFF_KR + SZ_KR;
constexpr size_t W_IN = 0, W_M = W_IN + 3584 * 1024 * 2, W_UQ = W_M + 3072 * 1024 * 2, W_UKV = W_UQ + 1024 * 256 * 2, W_BR = W_UKV + 1024 * 256 * 2, W_OUT = W_BR + 1024 * 1536 * 2, W_POOL = W_OUT + 1024 * 1024 * 2, W_LAYER = W_POOL + 4 * 128 * 128 * 2;
constexpr size_t OFF_SSQQ = OFF_W + 2 * W_LAYER, OFF_SSQKV = OFF_SSQQ + (size_t)M * 4, OFF_MOD = OFF_SSQKV + (size_t)M * 4, OFF_TAB = OFF_MOD + 2 * 33 * 3072 * 4, OFF_BAR = OFF_TAB + 64 * 8 * 8, WS_END = OFF_BAR + 16384;
constexpr size_t GSCR_PER_WG = 3 * 16 * 512 * 16;
static_assert(256 * GSCR_PER_WG <= SZ_Q, "gate scratch overlays Q");
static_assert(WS_END <= (size_t)1 << 30, "workspace");

constexpr int LDS_BYTES = 147456;
#ifndef DUP
#define DUP 0
#endif

__device__ __forceinline__ unsigned cvtpk(float lo, float hi) { f32x2 v = {lo, hi}; bf16x2_t b = __builtin_convertvector(v, bf16x2_t); return __builtin_bit_cast(unsigned, b); }
__device__ __forceinline__ bf16_t f2bf(float f) { return (bf16_t)(cvtpk(f, 0.f) & 0xffffu); }
__device__ __forceinline__ float bf2f(bf16_t b) { return __uint_as_float(((unsigned)b) << 16); }
__device__ __forceinline__ float bflo(unsigned u) { return __uint_as_float(u << 16); }
__device__ __forceinline__ float bfhi(unsigned u) { return __uint_as_float(u & 0xffff0000u); }
__device__ __forceinline__ float fexp2(float x) { return __builtin_amdgcn_exp2f(x); }
__device__ __forceinline__ float fexp(float x) { return __builtin_amdgcn_exp2f(x * 1.4426950408889634f); }
__device__ __forceinline__ float frcp(float x) { return __builtin_amdgcn_rcpf(x); }
__device__ __forceinline__ float sigmoidf_(float x) { return frcp(1.f + fexp(-x)); }
__device__ __forceinline__ float siluf_(float x) { return x * sigmoidf_(x); }
__device__ __forceinline__ float wave_sum(float v) {
#pragma unroll
    for (int o = 1; o < 64; o <<= 1) v += __shfl_xor(v, o);
    return v;
}
__device__ __forceinline__ int crow(int r, int hi) { return (r & 3) + 8 * (r >> 2) + 4 * hi; }
__device__ __forceinline__ u32x4 pack8(f32x4 a, f32x4 b) { u32x4 o; o.x = cvtpk(a[0], a[1]); o.y = cvtpk(a[2], a[3]); o.z = cvtpk(b[0], b[1]); o.w = cvtpk(b[2], b[3]); return o; }
__device__ __forceinline__ s16x4 trread(const LAS char* p) { return __builtin_bit_cast(s16x4, __builtin_amdgcn_ds_read_tr16_b64_v4i16((LAS s16x4*)p)); }
#define MK8(lo, hi) (bf16x8){lo[0], lo[1], lo[2], lo[3], hi[0], hi[1], hi[2], hi[3]}


#define XB_TMO      128
#define XB_XCNT(j)  (256  + 64 * (j))
#define XB_XSUB(j)  (1280 + 64 * (j))
#define XB_XGEN(j)  (2304 + 64 * (j))
#define XB_TOP      3328
#define XB_TOPGEN   3392
#define XCD_BAR_WORDS 3456
#define XB_SPIN_CAP (1u << 18)
__device__ __forceinline__ unsigned xb_ld(unsigned* p)              { return __hip_atomic_load(p, __ATOMIC_RELAXED, __HIP_MEMORY_SCOPE_AGENT); }
__device__ __forceinline__ unsigned xb_add(unsigned* p, unsigned v) { return __hip_atomic_fetch_add(p, v, __ATOMIC_RELAXED, __HIP_MEMORY_SCOPE_AGENT); }
__device__ __forceinline__ unsigned xb_xcc_id() { return (unsigned)__builtin_amdgcn_s_getreg((3 << 11) | 20) & 0xFu; }
#define XB_SPIN(cond, bar) do { unsigned _sp = 0; while (cond) { __builtin_amdgcn_s_sleep(1); \
    if ((++_sp & 255u) == 0u) { if (xb_ld(&(bar)[XB_TMO])) break; if (_sp > XB_SPIN_CAP) { atomicAdd(&(bar)[XB_TMO], 1u); break; } } } } while (0)
struct XcdBarrier { unsigned* bar; unsigned x; volatile LAS unsigned* st; };
__device__ __forceinline__ XcdBarrier xcd_barrier_post(unsigned* bar, volatile LAS unsigned* st) {
    XcdBarrier b; b.bar = bar; b.x = xb_xcc_id(); b.st = st;
    if (threadIdx.x == 0) (void)xb_add(&bar[XB_XCNT(b.x)], 1u);
    return b;
}
__device__ __forceinline__ void xcd_barrier_complete(unsigned* bar, unsigned x, unsigned& nloc, unsigned& nx) {
    const unsigned G = gridDim.x * gridDim.y * gridDim.z;
    unsigned sum, cnt, mine, sp = 0u;
    for (;;) {
        sum = 0u; cnt = 0u; mine = 0u;
#pragma unroll
        for (unsigned j = 0; j < 16; ++j) { const unsigned c = xb_ld(&bar[XB_XCNT(j)]); sum += c; cnt += (c > 0u) ? 1u : 0u; mine = (j == x) ? c : mine; }
        if (sum == G) break;
        __builtin_amdgcn_s_sleep(1);
        if ((++sp & 255u) == 0u) { if (xb_ld(&bar[XB_TMO])) break; if (sp > XB_SPIN_CAP) { atomicAdd(&bar[XB_TMO], 1u); break; } }
    }
    nloc = mine > 0u ? mine : 1u; nx = cnt > 0u ? cnt : 1u;
}
__device__ __forceinline__ void xcd_barrier(const XcdBarrier& b) {
    asm volatile("s_waitcnt vmcnt(0)" ::: "memory");
    __syncthreads();
    if (threadIdx.x == 0) {
        unsigned* bar = b.bar;
        __builtin_amdgcn_s_waitcnt(0);
        unsigned nloc = b.st[0], nx = b.st[1];
        if (nloc == 0u) { xcd_barrier_complete(bar, b.x, nloc, nx); b.st[0] = nloc; b.st[1] = nx; }
        const unsigned old = xb_add(&bar[XB_XSUB(b.x)], 1u);
        const unsigned gen = old / nloc;
        if (old + 1u == (gen + 1u) * nloc) {
            __builtin_amdgcn_fence(__ATOMIC_RELEASE, "agent");
            asm volatile("s_waitcnt vmcnt(0)" ::: "memory");
            const unsigned og = xb_add(&bar[XB_TOP], 1u);
            const unsigned tg = og / nx;
            if (og + 1u == (tg + 1u) * nx) xb_add(&bar[XB_TOPGEN], 1u);
            else XB_SPIN(xb_ld(&bar[XB_TOPGEN]) == tg, bar);
            __builtin_amdgcn_fence(__ATOMIC_ACQUIRE, "agent");
            xb_add(&bar[XB_XGEN(b.x)], 1u);
            asm volatile("s_waitcnt vmcnt(0)" ::: "memory");
        } else {
            XB_SPIN(xb_ld(&bar[XB_XGEN(b.x)]) == gen, bar);
            __builtin_amdgcn_fence(__ATOMIC_ACQUIRE, "agent");
            asm volatile("s_waitcnt vmcnt(0)" ::: "memory");
        }
    }
    __syncthreads();
}

struct Params {
    const float* x; const float* c; const float* ctx; const float* c_ctx; const float* mod_w; const float* mod_b; const float* pre_norm; const float* post_norm;
    const float* w_in; const float* mla_q_norm; const float* mla_w_uq; const float* mla_kv_norm; const float* mla_w_ukv; const float* pool_w; const float* pool_scale;
    const float* af_w2; const float* af_b; const float* ab_w2; const float* ab_b; const float* gla_norm; const float* w_bm; const float* w_bp; const float* w_bg; const float* w_out;
    float* out; unsigned char* ws; int ph_lo, ph_hi;
};

constexpr int BK = 64, HALF = 128, HTB = HALF * BK * 2;
__device__ __forceinline__ int lds_byte(int r, int c) { const int st = (r >> 4) * 2 + (c >> 5), rr = r & 15, cc = c & 31, ob = rr * 64 + cc * 2; return st * 1024 + (ob ^ (((ob >> 9) & 1) << 5)); }
__device__ __forceinline__ void stage_rc(int b, int& R, int& C) { const int st = b / 1024, sb = b % 1024, swz = sb ^ (((sb >> 9) & 1) << 5); R = (st >> 1) * 16 + swz / 64; C = (st & 1) * 32 + (swz % 64) / 2; }
__device__ __forceinline__ int perm32(int rho) { const int n = rho >> 4, i = rho & 15; return 8 * (i >> 2) + 4 * n + (i & 3); }

enum { EP_ZIN = 0, EP_Q = 1, EP_KV = 2, EP_GATE = 3, EP_MERGE = 4, EP_OUT = 5 };
struct GUnit { const char* A; const char* B; int lda2; int nt; int kind; int pm; int pn; int aux; };

__device__ __forceinline__ bool tile_of(long L, int nM, int nN, int& pm, int& pn) {
    const int nwg = nM * nN; if (L >= nwg) return false;
    int wgid = (int)L; { const int q = nwg / 8, r = nwg % 8, xcd = wgid % 8, off = wgid / 8; wgid = (xcd < r ? xcd * (q + 1) : r * (q + 1) + (xcd - r) * q) + off; }
    const int nig = 8 * nN, gid = wgid / nig, fm = gid * 8, gsz = (nM - fm) < 8 ? (nM - fm) : 8;
    pm = fm + ((wgid % nig) % gsz); pn = (wgid % nig) / gsz; return true;
}

struct GSched {
    int mode;
    int G, c; int latent_only;
    const char* Z; const char* H; const char* W;
    __device__ __forceinline__ int rowtile(int lt) const { return latent_only ? ((lt >> 3) * 9 + 1 + (lt & 7)) : lt; }
    __device__ __forceinline__ int nrt() const { return latent_only ? 256 : 288; }
    __device__ __forceinline__ bool next(int i, GUnit& u) const {
        int pm, pn;
        if (mode == 0) {
            if (latent_only) {
                const long L = (long)i * G + c;
                if (L < 256 * 14) { tile_of(L, 256, 14, pm, pn); pm = rowtile(pm); }
                else { const int L2 = (int)(L - 256 * 14); if (L2 >= 128) return false; pm = (L2 >> 2) * 9; const int q = L2 & 3; pn = (q == 0) ? 1 : (4 + q); }
            } else
            if (!tile_of((long)i * G + c, 288, 14, pm, pn)) return false;
            u.A = H + (size_t)pm * 256 * 2048; u.lda2 = 2048; u.B = W + W_IN + (size_t)pn * 256 * 2048; u.nt = 16; u.kind = EP_ZIN; u.pm = pm; u.pn = pn; u.aux = 0; return true;
        } else if (mode == 1) {
            const long L = (long)i * G + c; const int nq = nrt() * 4;
            if (L < nq) { tile_of(L, nrt(), 4, pm, pn); pm = rowtile(pm);
                u.A = Z + (size_t)pm * 256 * (ZP * 2) + ZQ * 2; u.lda2 = ZP * 2; u.B = W + W_UQ + (size_t)pn * 256 * 512; u.nt = 4; u.kind = EP_Q; u.pm = pm; u.pn = pn; u.aux = 0; return true; }
            if (!tile_of(L - nq, 288, 4, pm, pn)) return false;
            u.A = Z + (size_t)pm * 256 * (ZP * 2) + ZKV * 2; u.lda2 = ZP * 2; u.B = W + W_UKV + (size_t)pn * 256 * 512; u.nt = 4; u.kind = EP_KV; u.pm = pm; u.pn = pn; u.aux = 0; return true;
        } else if (mode == 2) {
            const int grp = i >> 2, sub = i & 3;
            if (!tile_of((long)grp * G + c, nrt(), 4, pm, pn)) return false;
            pm = rowtile(pm); u.pm = pm; u.pn = pn; u.aux = sub;
            if (sub < 3) { u.A = H + (size_t)pm * 256 * 2048; u.lda2 = 2048; u.B = W + W_M + (size_t)(sub * 1024 + pn * 256) * 2048; u.nt = 16; u.kind = EP_GATE; }
            else { u.A = Z + (size_t)pm * 256 * (ZP * 2) + ZYM * 2; u.lda2 = ZP * 2; u.B = W + W_BR + (size_t)pn * 256 * 3072; u.nt = 24; u.kind = EP_MERGE; }
            return true;
        } else {
            if (!tile_of((long)i * G + c, nrt(), 4, pm, pn)) return false;
            pm = rowtile(pm);
            u.A = Z + (size_t)pm * 256 * (ZP * 2); u.lda2 = ZP * 2; u.B = W + W_OUT + (size_t)pn * 256 * 2048; u.nt = 16; u.kind = EP_OUT; u.pm = pm; u.pn = pn; u.aux = 0; return true;
        }
    }
};

struct GEpi {
    bf16_t* Z; bf16_t* KR; float* ssq_q; float* ssq_kv; bf16_t* Qb; bf16_t* KVb; unsigned char* gscr; const f32x2* tab;
    __device__ __forceinline__ void mid(f32x4 (&acc)[2][2][4][2], int which, int tid) const {
        unsigned t16 = (unsigned)tid * 16u; asm volatile("" : "+v"(t16));
#pragma unroll
        for (int ab = 0; ab < 4; ++ab) {
            u32x4 ga[4], gb[4];
#pragma unroll
            for (int m = 0; m < 4; ++m) { const unsigned char* sb = gscr + (size_t)((which * 16 + ab * 4 + m) * 8192);
                ga[m] = *(const u32x4*)(sb + t16); gb[m] = *(const u32x4*)(sb + 16 * 8192 + t16); }
            __builtin_amdgcn_sched_barrier(0);
#pragma unroll
            for (int m = 0; m < 4; ++m) { f32x4& a0 = acc[ab >> 1][ab & 1][m][0]; f32x4& a1 = acc[ab >> 1][ab & 1][m][1];
                a0[0] *= (1.f + bflo(gb[m].x)) * frcp(1.f + bflo(ga[m].x)); a0[1] *= (1.f + bfhi(gb[m].x)) * frcp(1.f + bfhi(ga[m].x));
                a0[2] *= (1.f + bflo(gb[m].y)) * frcp(1.f + bflo(ga[m].y)); a0[3] *= (1.f + bfhi(gb[m].y)) * frcp(1.f + bfhi(ga[m].y));
                a1[0] *= (1.f + bflo(gb[m].z)) * frcp(1.f + bflo(ga[m].z)); a1[1] *= (1.f + bfhi(gb[m].z)) * frcp(1.f + bfhi(ga[m].z));
                a1[2] *= (1.f + bflo(gb[m].w)) * frcp(1.f + bflo(ga[m].w)); a1[3] *= (1.f + bfhi(gb[m].w)) * frcp(1.f + bfhi(ga[m].w)); }
            __builtin_amdgcn_sched_barrier(0);
        }
    }
    __device__ __forceinline__ void operator()(f32x4 (&acc)[2][2][4][2], const GUnit& u, int wr, int wc, int fr, int fq, int tid) const {
        const int k = u.kind;
        if (k == EP_ZIN) run<EP_ZIN>(acc, u, wr, wc, fr, fq, tid); else if (k == EP_Q) run<EP_Q>(acc, u, wr, wc, fr, fq, tid); else if (k == EP_KV) run<EP_KV>(acc, u, wr, wc, fr, fq, tid);
        else if (k == EP_GATE) run<EP_GATE>(acc, u, wr, wc, fr, fq, tid); else if (k == EP_MERGE) run<EP_MERGE>(acc, u, wr, wc, fr, fq, tid); else run<EP_OUT>(acc, u, wr, wc, fr, fq, tid);
    }
    template <int KIND> __device__ __forceinline__ void run(f32x4 (&acc)[2][2][4][2], const GUnit& u, int wr, int wc, int fr, int fq, int tid) const {
        constexpr int kind = KIND; const int pn = u.pn;
        unsigned t16 = (unsigned)tid * 16u; asm volatile("" : "+v"(t16));
        u32x4 ggv[16];
        if (kind == EP_MERGE) {
#pragma unroll
            for (int i = 0; i < 16; ++i) ggv[i] = *(const u32x4*)(gscr + (size_t)((2 * 16 + i) * 8192) + t16);
        } else {
#pragma unroll
            for (int i = 0; i < 16; ++i) ggv[i] = (u32x4){0u, 0u, 0u, 0u}; }
        __builtin_amdgcn_sched_barrier(0);
#pragma unroll
        for (int ai = 0; ai < 2; ++ai)
#pragma unroll
            for (int m = 0; m < 4; ++m) {
                const int row = u.pm * 256 + ai * 128 + wr * 64 + m * 16 + fr;
                if (kind == EP_ZIN) {
                    const int act = (pn == 4) ? 1 : (pn >= 8 ? 2 : 0);
                    float ss0 = 0.f, ss1 = 0.f;
#pragma unroll
                    for (int bj = 0; bj < 2; ++bj) {
                        f32x4 v0 = acc[ai][bj][m][0], v1 = acc[ai][bj][m][1];
                        if (act == 1) { v0 *= 0.125f; v1 *= 0.125f; }
                        if (act == 2) {
#pragma unroll
                            for (int j = 0; j < 4; ++j) { v0[j] = siluf_(v0[j]); v1[j] = siluf_(v1[j]); } }
                        *(u32x4*)(Z + (size_t)row * ZP + pn * 256 + bj * 128 + wc * 32 + 8 * fq) = pack8(v0, v1);
                        if (pn <= 1) { float s = 0.f;
#pragma unroll
                            for (int j = 0; j < 4; ++j) s += v0[j] * v0[j] + v1[j] * v1[j];
                            if (bj == 0) ss0 = s; else ss1 = s; }
                    }
                    if (pn <= 1) {
                        float s = (pn == 0) ? (ss0 + ss1) : ss0;
                        s += __shfl_xor(s, 16); s += __shfl_xor(s, 32);
                        if (fq == 0) atomicAdd((pn == 0 ? ssq_q : ssq_kv) + row, s);
                        if (pn == 1 && wc < 2) {
                            const f32x4 mn = acc[ai][1][m][0], rt = acc[ai][1][m][1]; f32x4 o = mn;
                            const int tok = row % TOK;
                            if (tok >= CTXL) { const int t = tok - CTXL; const int pos = (wc == 0) ? (t >> 6) : (t & 63);
#pragma unroll
                                for (int j = 0; j < 4; ++j) { const float rv = (float)pos * (fexp2(-(float)(4 * (fq & 1) + j) * (13.287712379549449f / 8.f)) * 0.15915494309189535f);     const float fr_ = rv - floorf(rv); o[j] = mn[j] * __builtin_amdgcn_cosf(fr_) + rt[j] * __builtin_amdgcn_sinf(fr_); } }
                            u32x2 pk; pk.x = cvtpk(o[0], o[1]); pk.y = cvtpk(o[2], o[3]);
                            *(u32x2*)(KR + (size_t)row * 32 + 4 * (4 * wc + fq)) = pk;
                        }
                    }
                } else if (kind == EP_Q) {
                    const float rs = __builtin_amdgcn_rsqf(ssq_q[row] * (1.f / 256.f) + EPS) * QSCALE;
                    const int tok = row % TOK;
#pragma unroll
                    for (int bj = 0; bj < 2; ++bj) {
                        const int head = 2 * pn + bj;
                        f32x4 v0 = acc[ai][bj][m][0] * rs, v1 = acc[ai][bj][m][1] * rs;
                        if (wc < 2) { *(u32x4*)(Qb + (size_t)row * 768 + head * 96 + wc * 32 + 8 * fq) = pack8(v0, v1); }
                        else { f32x4 o = v0; const int g = 4 * (wc - 2) + fq;
                            if (tok >= CTXL) { const int t = tok - CTXL; const int pos = (wc == 2) ? (t >> 6) : (t & 63);
#pragma unroll
                                for (int j = 0; j < 4; ++j) { const float rv = (float)pos * (fexp2(-(float)(4 * (fq & 1) + j) * (13.287712379549449f / 8.f)) * 0.15915494309189535f);     const float fr_ = rv - floorf(rv); o[j] = v0[j] * __builtin_amdgcn_cosf(fr_) + v1[j] * __builtin_amdgcn_sinf(fr_); } }
                            u32x2 pk; pk.x = cvtpk(o[0], o[1]); pk.y = cvtpk(o[2], o[3]);
                            *(u32x2*)(Qb + (size_t)row * 768 + head * 96 + 64 + 4 * g) = pk; }
                    }
                } else if (kind == EP_KV) {
                    const float rs = __builtin_amdgcn_rsqf(ssq_kv[row] * (1.f / 128.f) + EPS);
#pragma unroll
                    for (int bj = 0; bj < 2; ++bj)
                        *(u32x4*)(KVb + (size_t)row * 1024 + pn * 256 + bj * 128 + wc * 32 + 8 * fq) = pack8(acc[ai][bj][m][0] * rs, acc[ai][bj][m][1] * rs);
                } else if (kind == EP_GATE) {
#pragma unroll
                    for (int bj = 0; bj < 2; ++bj) { f32x4 v0 = acc[ai][bj][m][0], v1 = acc[ai][bj][m][1];
#pragma unroll
                        for (int j = 0; j < 4; ++j) { v0[j] = fminf(fexp(-v0[j]), 1e18f); v1[j] = fminf(fexp(-v1[j]), 1e18f); }
                        *(u32x4*)(gscr + (size_t)((u.aux * 16 + (ai * 2 + bj) * 4 + m) * 8192) + t16) = pack8(v0, v1); }
                } else if (kind == EP_MERGE) {
#pragma unroll
                    for (int bj = 0; bj < 2; ++bj) {
                        const u32x4 gg = ggv[(ai * 2 + bj) * 4 + m];
                        f32x4 v0 = acc[ai][bj][m][0], v1 = acc[ai][bj][m][1];
                        v0[0] *= frcp(1.f + bflo(gg.x)); v0[1] *= frcp(1.f + bfhi(gg.x)); v0[2] *= frcp(1.f + bflo(gg.y)); v0[3] *= frcp(1.f + bfhi(gg.y));
                        v1[0] *= frcp(1.f + bflo(gg.z)); v1[1] *= frcp(1.f + bfhi(gg.z)); v1[2] *= frcp(1.f + bflo(gg.w)); v1[3] *= frcp(1.f + bfhi(gg.w));
                        *(u32x4*)(Z + (size_t)row * ZP + pn * 256 + bj * 128 + wc * 32 + 8 * fq) = pack8(v0, v1); }
                } else {
#pragma unroll
                    for (int bj = 0; bj < 2; ++bj)
                        *(u32x4*)(Z + (size_t)row * ZP + 1024 + pn * 256 + bj * 128 + wc * 32 + 8 * fq) = pack8(acc[ai][bj][m][0], acc[ai][bj][m][1]);
                }
                __builtin_amdgcn_sched_barrier(0);
            }
    }
};

__device__ __forceinline__ void gemm_phase(LAS unsigned char* lds, const GSched& S, const GEpi& E, bool dry) {
    int tid = threadIdx.x; asm volatile("" : "+v"(tid)); const int wid = __builtin_amdgcn_readfirstlane(tid >> 6), lane = tid & 63, wr = wid >> 2, wc = wid & 3, fr = lane & 15, fq = lane >> 4;
    int R0, C0; stage_rc(tid * 16, R0, C0);
    const int Rb0 = (R0 & ~31) + perm32(R0 & 31); const int C02 = C0 * 2;
    const unsigned ldsw = (unsigned)wid * 1024u;
    const int aoff = lds_byte(wr * 64 + fr, fq * 8), boff = lds_byte(wc * 32 + fr, fq * 8);
#define PG8_SA(b, h) (((b) * 2 + (h)) * HTB)
#define PG8_SB(b, h) ((4 + (b) * 2 + (h)) * HTB)
#define PG8_STAGE(bufoff, gbase, ld, rowv) do { const unsigned _v = (unsigned)((rowv) * (ld) + C02); \
        __builtin_amdgcn_global_load_lds((const unsigned*)((const char*)(gbase) + _v), (LAS unsigned*)(lds + (bufoff) + ldsw), 16, 0, 0); \
        __builtin_amdgcn_global_load_lds((const unsigned*)((const char*)(gbase) + (size_t)64 * (ld) + _v), (LAS unsigned*)(lds + (bufoff) + ldsw + 8192), 16, 0, 0); } while (0)
#define PG8_LDA(dst, b, h) do { _Pragma("unroll") for (int m = 0; m < 4; ++m) _Pragma("unroll") for (int k = 0; k < 2; ++k) dst[m][k] = *(const LAS bf16x8*)(lds + PG8_SA(b, h) + aoff + m * 2048 + k * 1024); } while (0)
#define PG8_LDB(dst, b, h) do { _Pragma("unroll") for (int n = 0; n < 2; ++n) _Pragma("unroll") for (int k = 0; k < 2; ++k) dst[n][k] = *(const LAS bf16x8*)(lds + PG8_SB(b, h) + boff + n * 2048 + k * 1024); } while (0)
#define PG8_MMA(ai, bj, At, Bt) do { __builtin_amdgcn_s_setprio(1); _Pragma("unroll") for (int m = 0; m < 4; ++m) _Pragma("unroll") for (int n = 0; n < 2; ++n) _Pragma("unroll") for (int k = 0; k < 2; ++k) \
        acc[ai][bj][m][n] = __builtin_amdgcn_mfma_f32_16x16x32_bf16(Bt[n][k], At[m][k], acc[ai][bj][m][n], 0, 0, 0); __builtin_amdgcn_s_setprio(0); } while (0)
#define PG8_WAIT_V(n) asm volatile("s_waitcnt vmcnt(" #n ")" ::: "memory")
#define PG8_WAIT_L(n) asm volatile("s_waitcnt lgkmcnt(" #n ")" ::: "memory")
#define PG8_BAR __builtin_amdgcn_s_barrier()
#define PG8_SCHED __builtin_amdgcn_sched_barrier(0)
    GUnit cur, nxt; int ui = 0;
    if (!S.next(0, cur)) return;
    f32x4 acc[2][2][4][2];
#pragma unroll
    for (int a = 0; a < 2; ++a)
#pragma unroll
        for (int b = 0; b < 2; ++b)
#pragma unroll
            for (int m = 0; m < 4; ++m)
#pragma unroll
                for (int n = 0; n < 2; ++n) acc[a][b][m][n] = (f32x4){0.f, 0.f, 0.f, 0.f};
    bf16x8 At[4][2], B0[2][2], B1[2][2];
    const char* cA = cur.A; const char* cB = cur.B;
    int ldA = cur.lda2, ldB = cur.nt * 128;
    const size_t kstep = 128;
    PG8_STAGE(PG8_SB(0, 0), cB, ldB, Rb0); PG8_STAGE(PG8_SB(0, 1), cB + (size_t)HALF * ldB, ldB, Rb0); PG8_STAGE(PG8_SA(0, 0), cA, ldA, R0); PG8_STAGE(PG8_SA(0, 1), cA + (size_t)HALF * ldA, ldA, R0);
    if (wr == 1) PG8_BAR;
    PG8_WAIT_V(2); PG8_BAR;
    PG8_STAGE(PG8_SB(1, 0), cB + kstep, ldB, Rb0); PG8_STAGE(PG8_SA(1, 0), cA + kstep, ldA, R0); PG8_STAGE(PG8_SB(1, 1), cB + (size_t)HALF * ldB + kstep, ldB, Rb0);
    PG8_WAIT_V(6); PG8_BAR;
    for (;;) {
        const bool has_next = S.next(ui + 1, nxt);
        const char* nA = has_next ? nxt.A : cA; const char* nB = has_next ? nxt.B : cB;
        const int nldA = has_next ? nxt.lda2 : ldA, nldB = has_next ? nxt.nt * 128 : ldB;
        const int nt = cur.nt;
        for (int t = 0; t < nt; t += 2) {
            const bool last = (t == nt - 2);
            if (cur.kind == EP_MERGE && (t == 8 || t == 16)) E.mid(acc, t == 8 ? 0 : 1, tid);
            const char* a1 = cA + (size_t)(t + 1) * kstep;
            const char* a2 = last ? nA : cA + (size_t)(t + 2) * kstep; const char* b2 = last ? nB : cB + (size_t)(t + 2) * kstep;
            const char* a3 = a2 + kstep; const char* b3 = b2 + kstep;
            const int xldA = last ? nldA : ldA, xldB = last ? nldB : ldB;
            PG8_LDB(B0, 0, 0); PG8_LDB(B1, 0, 1); PG8_SCHED; PG8_LDA(At, 0, 0); PG8_STAGE(PG8_SA(1, 1), a1 + (size_t)HALF * ldA, ldA, R0);
            PG8_WAIT_V(8); PG8_WAIT_L(0); PG8_BAR; PG8_MMA(0, 0, At, B0); PG8_MMA(0, 1, At, B1); PG8_BAR; PG8_SCHED;
            PG8_LDA(At, 0, 1); PG8_STAGE(PG8_SB(0, 0), b2, xldB, Rb0); PG8_STAGE(PG8_SB(0, 1), b2 + (size_t)HALF * xldB, xldB, Rb0); PG8_STAGE(PG8_SA(0, 0), a2, xldA, R0);
            PG8_WAIT_V(8); PG8_WAIT_L(0); PG8_BAR; PG8_MMA(1, 0, At, B0); PG8_MMA(1, 1, At, B1); PG8_BAR; PG8_SCHED;
            PG8_LDB(B0, 1, 0); PG8_LDB(B1, 1, 1); PG8_SCHED; PG8_LDA(At, 1, 0); PG8_STAGE(PG8_SA(0, 1), a2 + (size_t)HALF * xldA, xldA, R0);
            PG8_WAIT_V(8); PG8_WAIT_L(0); PG8_BAR; PG8_MMA(0, 0, At, B0); PG8_MMA(0, 1, At, B1); PG8_BAR; PG8_SCHED;
            PG8_LDA(At, 1, 1); PG8_STAGE(PG8_SB(1, 0), b3, xldB, Rb0); PG8_STAGE(PG8_SB(1, 1), b3 + (size_t)HALF * xldB, xldB, Rb0); PG8_STAGE(PG8_SA(1, 0), a3, xldA, R0);
            PG8_WAIT_V(8); PG8_WAIT_L(0); PG8_BAR; PG8_MMA(1, 0, At, B0); PG8_MMA(1, 1, At, B1); PG8_BAR; PG8_SCHED;
        }
        if (wr == 0) PG8_BAR;
        if (!dry) E(acc, cur, wr, wc, fr, fq, tid);
        if (!has_next) break;
#pragma unroll
        for (int a = 0; a < 2; ++a)
#pragma unroll
            for (int b = 0; b < 2; ++b)
#pragma unroll
                for (int m = 0; m < 4; ++m)
#pragma unroll
                    for (int n = 0; n < 2; ++n) acc[a][b][m][n] = (f32x4){0.f, 0.f, 0.f, 0.f};
        cur = nxt; cA = nA; cB = nB; ldA = nldA; ldB = nldB; ++ui;
        if (wr == 1) PG8_BAR;
    }
    PG8_WAIT_V(0);
    PG8_BAR;
}

constexpr int AK_PITCH = 208, AK_BYTES = 64 * AK_PITCH, AV_BYTES = 8192;
constexpr int A_K0 = 0, A_V0 = 4 * AK_BYTES, A_WS = A_V0 + 4 * AV_BYTES, A_OST = A_WS + 2048, A_OP = 144, A_END = A_OST + 8 * 32 * A_OP;
static_assert(A_END <= 147200, "attention lds");
__device__ __forceinline__ float max3f(float a, float b, float c) { return fmaxf(fmaxf(a, b), c); }
__device__ __forceinline__ void attn_unit(LAS char* lds, const bf16_t* Qp, const bf16_t* KVp, const bf16_t* KRp, int ntiles, bf16_t* Yp, bool dry) {
    int tid = threadIdx.x; asm volatile("" : "+v"(tid)); const int lane = tid & 63, r32 = lane & 31, hi = lane >> 5; const int wid = __builtin_amdgcn_readfirstlane(tid >> 6);
    LAS float* wsf = (LAS float*)(lds + A_WS) + wid * 64;
    const int krow = tid >> 3, kc = tid & 7, rrow = tid >> 2, rc = tid & 3;
    const bf16_t* gk = KVp + (size_t)krow * 1024 + kc * 8;
    const bf16_t* gv = gk + 512;
    const bf16_t* gr = KRp + (size_t)rrow * 32 + rc * 8;
    const int lk = krow * AK_PITCH + kc * 16, lr = rrow * AK_PITCH + 128 + rc * 16, lv = (kc >> 2) * 4096 + krow * 64 + (kc & 3) * 16;
    const bool rth = tid < 256;
    u32x4 skA, svA, srA = {0u, 0u, 0u, 0u}, skB, svB, srB = {0u, 0u, 0u, 0u};
#define AT_LOAD(X, t) do { const size_t adv_ = (size_t)(t) * 64; sk##X = *(const u32x4*)(gk + adv_ * 1024); sv##X = *(const u32x4*)(gv + adv_ * 1024); if (rth) sr##X = *(const u32x4*)(gr + adv_ * 32); } while (0)
#define AT_STORE(X, slot) do { *(LAS u32x4*)(lds + A_K0 + (slot) * AK_BYTES + lk) = sk##X; *(LAS u32x4*)(lds + A_V0 + (slot) * AV_BYTES + lv) = sv##X; if (rth) *(LAS u32x4*)(lds + A_K0 + (slot) * AK_BYTES + lr) = sr##X; } while (0)
    AT_LOAD(A, 0); AT_LOAD(B, 1);
    bf16x8 qf[6];
    { const bf16_t* qrow = Qp + (size_t)(wid * 32 + r32) * 768;
#pragma unroll
      for (int s = 0; s < 6; ++s) qf[s] = *(const bf16x8*)(qrow + 16 * s + 8 * hi); }
    AT_STORE(A, 0); AT_STORE(B, 1);
    __syncthreads();
    float mref = 0.f, lsum = 0.f;
    f32x16 o0 = {}, o1 = {};
    const int g16 = (lane >> 4) & 1, q4 = (lane & 15) >> 2, p4 = lane & 3;
    const int vtr = (4 * hi + q4) * 64 + (16 * g16 + 4 * p4) * 2;
#define AT_QK(slot, P0, P1) do { const LAS char* Kb = lds + A_K0 + (slot) * AK_BYTES; \
        _Pragma("unroll") for (int s = 0; s < 6; ++s) { \
            const bf16x8 k0 = *(const LAS bf16x8*)(Kb + r32 * AK_PITCH + (16 * s + 8 * hi) * 2); \
            const bf16x8 k1 = *(const LAS bf16x8*)(Kb + (r32 + 32) * AK_PITCH + (16 * s + 8 * hi) * 2); \
            P0 = __builtin_amdgcn_mfma_f32_32x32x16_bf16(k0, qf[s], P0, 0, 0, 0); P1 = __builtin_amdgcn_mfma_f32_32x32x16_bf16(k1, qf[s], P1, 0, 0, 0); } } while (0)
#define AT_SMPV(slot, first, p0, p1) do { const LAS char* Vb = lds + A_V0 + (slot) * AV_BYTES; \
        float ra = max3f(p0[0], p0[1], p1[0]), rb = max3f(p0[2], p0[3], p1[1]); ra = max3f(ra, p1[2], p1[3]); \
        _Pragma("unroll") for (int r = 4; r < 16; r += 4) { ra = max3f(ra, p0[r], p0[r + 1]); rb = max3f(rb, p0[r + 2], p0[r + 3]); ra = max3f(ra, p1[r], p1[r + 1]); rb = max3f(rb, p1[r + 2], p1[r + 3]); } \
        float rm = fmaxf(ra, rb); rm = fmaxf(rm, __shfl_xor(rm, 32)) - mref; \
        if ((first) || __any(rm > 8.f)) { \
            const float dl = (first) ? rm : fmaxf(rm, 0.f); mref += dl; const float al = fexp2(-dl); lsum *= al; \
            if (!(first)) { if (hi == 0) wsf[r32] = al; \
                asm volatile("s_waitcnt lgkmcnt(0)" ::: "memory"); \
                _Pragma("unroll") for (int k = 0; k < 4; ++k) { const f32x4 a = *(const LAS f32x4*)(wsf + 8 * k + 4 * hi); \
                    _Pragma("unroll") for (int j = 0; j < 4; ++j) { o0[4 * k + j] *= a[j]; o1[4 * k + j] *= a[j]; } } } \
        } \
        _Pragma("unroll") for (int r = 0; r < 16; ++r) { p0[r] = fexp2(p0[r] - mref); p1[r] = fexp2(p1[r] - mref); } \
        { float sa = p0[0] + p1[0], sb = p0[1] + p1[1], sc_ = p0[2] + p1[2], sd = p0[3] + p1[3]; \
          _Pragma("unroll") for (int r = 4; r < 16; r += 4) { sa += p0[r] + p1[r]; sb += p0[r + 1] + p1[r + 1]; sc_ += p0[r + 2] + p1[r + 2]; sd += p0[r + 3] + p1[r + 3]; } \
          lsum += (sa + sb) + (sc_ + sd); } \
        u32x4 pw[4]; \
        pw[0] = (u32x4){cvtpk(p0[0], p0[1]), cvtpk(p0[2], p0[3]), cvtpk(p0[4], p0[5]), cvtpk(p0[6], p0[7])}; \
        pw[1] = (u32x4){cvtpk(p0[8], p0[9]), cvtpk(p0[10], p0[11]), cvtpk(p0[12], p0[13]), cvtpk(p0[14], p0[15])}; \
        pw[2] = (u32x4){cvtpk(p1[0], p1[1]), cvtpk(p1[2], p1[3]), cvtpk(p1[4], p1[5]), cvtpk(p1[6], p1[7])}; \
        pw[3] = (u32x4){cvtpk(p1[8], p1[9]), cvtpk(p1[10], p1[11]), cvtpk(p1[12], p1[13]), cvtpk(p1[14], p1[15])}; \
        _Pragma("unroll") for (int u = 0; u < 4; ++u) { \
            const LAS char* vb = Vb + vtr + u * 16 * 64; \
            const s16x4 a0 = trread(vb), a1 = trread(vb + 8 * 64), b0 = trread(vb + 4096), b1 = trread(vb + 4096 + 8 * 64); \
            o0 = __builtin_amdgcn_mfma_f32_32x32x16_bf16(__builtin_bit_cast(bf16x8, pw[u]), MK8(a0, a1), o0, 0, 0, 0); \
            o1 = __builtin_amdgcn_mfma_f32_32x32x16_bf16(__builtin_bit_cast(bf16x8, pw[u]), MK8(b0, b1), o1, 0, 0, 0); } \
    } while (0)
    for (int t = 0; t < ntiles; t += 2) {
        const int sb0 = (t & 2);
        const bool more = (t + 2 < ntiles);
        f32x16 pa0 = {}, pa1 = {}, pb0 = {}, pb1 = {};
        AT_QK(sb0, pa0, pa1);
        AT_QK(sb0 + 1, pb0, pb1);
        if (t == 0) AT_SMPV(sb0, true, pa0, pa1); else AT_SMPV(sb0, false, pa0, pa1);
        __builtin_amdgcn_sched_barrier(0);
        if (more) { AT_LOAD(A, t + 2); AT_LOAD(B, t + 3); }
        AT_SMPV(sb0 + 1, false, pb0, pb1);
        if (more) { AT_STORE(A, sb0 ^ 2); AT_STORE(B, (sb0 ^ 2) + 1); }
        __syncthreads();
    }
#undef AT_LOAD
#undef AT_STORE
#undef AT_QK
#undef AT_SMPV
    lsum += __shfl_xor(lsum, 32);
    if (hi == 0) wsf[r32] = frcp(lsum);
    asm volatile("s_waitcnt lgkmcnt(0)" ::: "memory");
    LAS char* ost = lds + A_OST + wid * (32 * A_OP);
#pragma unroll
    for (int k = 0; k < 4; ++k) { const f32x4 a = *(const LAS f32x4*)(wsf + 8 * k + 4 * hi);
#pragma unroll
        for (int j = 0; j < 4; ++j) { const int r = 4 * k + j; LAS bf16_t* op = (LAS bf16_t*)(ost + crow(r, hi) * A_OP) + r32;
            op[0] = f2bf(o0[r] * a[j]); op[32] = f2bf(o1[r] * a[j]); } }
    asm volatile("s_waitcnt lgkmcnt(0)" ::: "memory");
#pragma unroll
    for (int i = 0; i < 4; ++i) { const int id = lane + 64 * i, row = id >> 3, ch = id & 7;
        const u32x4 ov = *(const LAS u32x4*)(ost + row * A_OP + ch * 16);
        bf16_t* yp = Yp + (size_t)(wid * 32 + row) * ZP + ch * 8;
        if (!dry) { const u32x4 gv = *(const u32x4*)yp; u32x4 w;
            w.x = cvtpk(bflo(ov.x) * bflo(gv.x), bfhi(ov.x) * bfhi(gv.x)); w.y = cvtpk(bflo(ov.y) * bflo(gv.y), bfhi(ov.y) * bfhi(gv.y));
            w.z = cvtpk(bflo(ov.z) * bflo(gv.z), bfhi(ov.z) * bfhi(gv.z)); w.w = cvtpk(bflo(ov.w) * bflo(gv.w), bfhi(ov.w) * bfhi(gv.w));
            *(u32x4*)yp = w; } }
    __syncthreads();
}

constexpr int GP = 144, GARR = 64 * GP;
constexpr int G_Q = 0, G_K = GARR, G_KD = 2 * GARR, G_V = 3 * GARR, G_AM = 4 * GARR, G_SB = 5 * GARR, G_O = 6 * GARR, G_A16 = 7 * GARR, G_DEC = G_A16 + 2048, G_TOT = G_DEC + 256, G_GROUP = 68096;
static_assert(G_TOT + 512 <= G_GROUP && 2 * G_GROUP <= 147200, "gla lds");
__device__ __forceinline__ void gla_unit(LAS char* lds0, int b, int h, int dvh, bf16_t* Z, bf16_t* OT, const float* afw, const float* afb, const float* abw, const float* abb, bool dry) {
    int tid = threadIdx.x; asm volatile("" : "+v"(tid)); const int lane = tid & 63, r32 = lane & 31, hi = lane >> 5; const int wid = __builtin_amdgcn_readfirstlane(tid >> 6);
    const int dir = wid >> 2, wg = wid & 3, tg = tid & 255;
    LAS char* lds = lds0 + dir * G_GROUP;
    const int g16 = (lane >> 4) & 1, q4 = (lane & 15) >> 2, p4 = lane & 3;
    const int I = wg >> 1, J = wg & 1;
    const float* w2 = dir ? abw : afw; const float* bb = dir ? abb : afb;
    bf16x8 w2b;
    { u32x4 t; t.x = cvtpk(w2[(8 * hi + 0) * 256 + h * 64 + 32 * J + r32], w2[(8 * hi + 1) * 256 + h * 64 + 32 * J + r32]);
      t.y = cvtpk(w2[(8 * hi + 2) * 256 + h * 64 + 32 * J + r32], w2[(8 * hi + 3) * 256 + h * 64 + 32 * J + r32]);
      t.z = cvtpk(w2[(8 * hi + 4) * 256 + h * 64 + 32 * J + r32], w2[(8 * hi + 5) * 256 + h * 64 + 32 * J + r32]);
      t.w = cvtpk(w2[(8 * hi + 6) * 256 + h * 64 + 32 * J + r32], w2[(8 * hi + 7) * 256 + h * 64 + 32 * J + r32]);
      w2b = __builtin_bit_cast(bf16x8, t); }
    const float bias = bb[h * 64 + 32 * J + r32];
    const int zcol_a = dir ? ZAB : ZAF;
    f32x16 S = {};
    for (int i = tg; i < GARR / 4; i += 256) ((LAS unsigned*)(lds + G_SB))[i] = 0u;
    u32x4 pq0, pq1, pk0, pk1, pv0, pv1; u32x2 pa;
    const int lr = tg >> 3, lc = tg & 7, ar = tg >> 2, ac = tg & 3;
#define GLA_CHUNK(s) (dir ? ((s) < 4 ? 3 - (s) : 39 - (s)) : (s))
#define GLA_ROW(rb, i) ((rb) + (dir ? 63 - (i) : (i)))
#define GLA_PREFETCH(s) do { const size_t rb_ = (size_t)b * TOK + 64 * GLA_CHUNK(s); \
        const bf16_t* z0_ = Z + GLA_ROW(rb_, lr) * ZP; const bf16_t* z1_ = Z + GLA_ROW(rb_, lr + 32) * ZP; \
        pq0 = *(const u32x4*)(z0_ + ZGQ + h * 64 + lc * 8); pq1 = *(const u32x4*)(z1_ + ZGQ + h * 64 + lc * 8); \
        pk0 = *(const u32x4*)(z0_ + ZGK + h * 64 + lc * 8); pk1 = *(const u32x4*)(z1_ + ZGK + h * 64 + lc * 8); \
        pv0 = *(const u32x4*)(z0_ + ZGV + h * 128 + dvh * 64 + lc * 8); pv1 = *(const u32x4*)(z1_ + ZGV + h * 128 + dvh * 64 + lc * 8); \
        pa = *(const u32x2*)(Z + GLA_ROW(rb_, ar) * ZP + zcol_a + ac * 4); } while (0)
    GLA_PREFETCH(0);
    for (int s = 0; s < 36; ++s) {
        const int c = GLA_CHUNK(s);
        const size_t rbase = (size_t)b * TOK + 64 * c;
        const int other_step = dir ? c : (c < 4 ? 3 - c : 39 - c);
        const bool second = s > other_step;
        *(LAS u32x4*)(lds + G_Q + lr * GP + lc * 16) = pq0; *(LAS u32x4*)(lds + G_Q + (lr + 32) * GP + lc * 16) = pq1;
        *(LAS u32x4*)(lds + G_K + lr * GP + lc * 16) = pk0; *(LAS u32x4*)(lds + G_K + (lr + 32) * GP + lc * 16) = pk1;
        *(LAS u32x4*)(lds + G_V + lr * GP + lc * 16) = pv0; *(LAS u32x4*)(lds + G_V + (lr + 32) * GP + lc * 16) = pv1;
        *(LAS u32x2*)(lds + G_A16 + ar * 32 + ac * 8) = pa;
        __syncthreads();
        if (s + 1 < 36) GLA_PREFETCH(s + 1);
        u32x4 prv0 = {0u, 0u, 0u, 0u}, prv1 = {0u, 0u, 0u, 0u};
        bf16_t* og0 = OT + GLA_ROW(rbase, lr) * 512 + h * 128 + dvh * 64 + lc * 8;
        bf16_t* og1 = OT + GLA_ROW(rbase, lr + 32) * 512 + h * 128 + dvh * 64 + lc * 8;
        if (second) { prv0 = *(const u32x4*)og0; prv1 = *(const u32x4*)og1; }
        float cs[16];
        {
            f32x16 zc;
#pragma unroll
            for (int r = 0; r < 16; ++r) zc[r] = bias;
            const bf16x8 a = *(const LAS bf16x8*)(lds + G_A16 + (32 * I + r32) * 32 + hi * 16);
            zc = __builtin_amdgcn_mfma_f32_32x32x16_bf16(a, w2b, zc, 0, 0, 0);
#pragma unroll
            for (int r = 0; r < 16; ++r) { const float z = zc[r]; cs[r] = (fminf(z, 0.f) - __logf(1.f + fexp(-fabsf(z)))) * (1.f / 16.f); }
        }
#pragma unroll
        for (int g = 0; g < 4; ++g) { cs[4 * g + 1] += cs[4 * g]; cs[4 * g + 2] += cs[4 * g + 1]; cs[4 * g + 3] += cs[4 * g + 2]; }
        float run = 0.f;
#pragma unroll
        for (int g = 0; g < 4; ++g) {
            const float mine = cs[4 * g + 3]; const float oth = __shfl_xor(mine, 32);
            const float off = run + (hi ? oth : 0.f);
#pragma unroll
            for (int j = 0; j < 4; ++j) cs[4 * g + j] += off;
            run += mine + oth;
        }
        if (hi == 0) ((LAS float*)(lds + G_TOT))[I * 64 + 32 * J + r32] = run;
        asm volatile("s_waitcnt lgkmcnt(0)\n\ts_barrier" ::: "memory");
        const float t0v = ((LAS float*)(lds + G_TOT))[32 * J + r32], t1v = ((LAS float*)(lds + G_TOT))[64 + 32 * J + r32];
        const float pre = I ? t0v : 0.f, tot = t0v + t1v;
        const float etot = fexp(tot);
#pragma unroll
        for (int r = 0; r < 16; ++r) {
            const int ii = 32 * I + crow(r, hi), dd = 32 * J + r32; const float eb = fexp(pre + cs[r]); const float ieb = frcp(eb);
            LAS bf16_t* qp = (LAS bf16_t*)(lds + G_Q) + ii * (GP / 2) + dd; LAS bf16_t* kp = (LAS bf16_t*)(lds + G_K) + ii * (GP / 2) + dd;
            const float qv = bf2f(*qp), kv = bf2f(*kp);
            *qp = f2bf(qv * eb); *kp = f2bf(kv * ieb);
            ((LAS bf16_t*)(lds + G_KD))[ii * (GP / 2) + dd] = f2bf(kv * ieb * etot);
        }
        if (I == 0 && hi == 0) ((LAS float*)(lds + G_DEC))[32 * J + r32] = etot;
        asm volatile("s_waitcnt lgkmcnt(0)\n\ts_barrier" ::: "memory");
        f32x16 oacc = {};
        {
            f32x16 Ac = {};
            if (J <= I) {
#pragma unroll
                for (int k = 0; k < 4; ++k) {
                    const bf16x8 a = *(const LAS bf16x8*)(lds + G_Q + (32 * I + r32) * GP + (16 * k + 8 * hi) * 2);
                    const bf16x8 bq = *(const LAS bf16x8*)(lds + G_K + (32 * J + r32) * GP + (16 * k + 8 * hi) * 2);
                    Ac = __builtin_amdgcn_mfma_f32_32x32x16_bf16(a, bq, Ac, 0, 0, 0);
                }
            }
#pragma unroll
            for (int k = 0; k < 4; ++k) {
                const bf16x8 a = *(const LAS bf16x8*)(lds + G_Q + (32 * I + r32) * GP + (16 * k + 8 * hi) * 2);
                const LAS char* sp = lds + G_SB + (16 * k + 8 * hi + q4) * GP + (32 * J + 16 * g16 + 4 * p4) * 2;
                const s16x4 l0 = trread(sp), l1 = trread(sp + 4 * GP);
                oacc = __builtin_amdgcn_mfma_f32_32x32x16_bf16(a, MK8(l0, l1), oacc, 0, 0, 0);
            }
#pragma unroll
            for (int r = 0; r < 16; ++r) { const int i_ = 32 * I + crow(r, hi), j_ = 32 * J + r32;
                ((LAS bf16_t*)(lds + G_AM))[i_ * (GP / 2) + j_] = f2bf((i_ >= j_) ? Ac[r] : 0.f); }
        }
        asm volatile("s_waitcnt lgkmcnt(0)\n\ts_barrier" ::: "memory");
        {
#pragma unroll
            for (int u = 0; u < 4; ++u) {
                const bf16x8 a = *(const LAS bf16x8*)(lds + G_AM + (32 * I + r32) * GP + (16 * u + 8 * hi) * 2);
                const LAS char* vp = lds + G_V + (16 * u + 8 * hi + q4) * GP + (32 * J + 16 * g16 + 4 * p4) * 2;
                const s16x4 l0 = trread(vp), l1 = trread(vp + 4 * GP);
                oacc = __builtin_amdgcn_mfma_f32_32x32x16_bf16(a, MK8(l0, l1), oacc, 0, 0, 0);
            }
#pragma unroll
            for (int r = 0; r < 16; ++r) ((LAS bf16_t*)(lds + G_O))[(32 * I + crow(r, hi)) * (GP / 2) + 32 * J + r32] = f2bf(oacc[r]);
            const int Dd = I;
#pragma unroll
            for (int k = 0; k < 4; ++k) { const f32x4 dc = *(const LAS f32x4*)(lds + G_DEC + (32 * Dd + 8 * k + 4 * hi) * 4);
#pragma unroll
                for (int j = 0; j < 4; ++j) S[4 * k + j] *= dc[j]; }
#pragma unroll
            for (int u = 0; u < 4; ++u) {
                const LAS char* kp = lds + G_KD + (16 * u + 8 * hi + q4) * GP + (32 * Dd + 16 * g16 + 4 * p4) * 2;
                const LAS char* vp = lds + G_V + (16 * u + 8 * hi + q4) * GP + (32 * J + 16 * g16 + 4 * p4) * 2;
                const s16x4 k0 = trread(kp), k1 = trread(kp + 4 * GP), v0 = trread(vp), v1 = trread(vp + 4 * GP);
                S = __builtin_amdgcn_mfma_f32_32x32x16_bf16(MK8(k0, k1), MK8(v0, v1), S, 0, 0, 0);
            }
        }
        asm volatile("s_waitcnt lgkmcnt(0)\n\ts_barrier" ::: "memory");
#pragma unroll
        for (int r = 0; r < 16; ++r) ((LAS bf16_t*)(lds + G_SB))[(32 * I + crow(r, hi)) * (GP / 2) + 32 * J + r32] = f2bf(S[r]);
        {
            u32x4 o0v = *(const LAS u32x4*)(lds + G_O + lr * GP + lc * 16), o1v = *(const LAS u32x4*)(lds + G_O + (lr + 32) * GP + lc * 16);
            if (second) {
                o0v.x = cvtpk(bflo(o0v.x) + bflo(prv0.x), bfhi(o0v.x) + bfhi(prv0.x)); o0v.y = cvtpk(bflo(o0v.y) + bflo(prv0.y), bfhi(o0v.y) + bfhi(prv0.y));
                o0v.z = cvtpk(bflo(o0v.z) + bflo(prv0.z), bfhi(o0v.z) + bfhi(prv0.z)); o0v.w = cvtpk(bflo(o0v.w) + bflo(prv0.w), bfhi(o0v.w) + bfhi(prv0.w));
                o1v.x = cvtpk(bflo(o1v.x) + bflo(prv1.x), bfhi(o1v.x) + bfhi(prv1.x)); o1v.y = cvtpk(bflo(o1v.y) + bflo(prv1.y), bfhi(o1v.y) + bfhi(prv1.y));
                o1v.z = cvtpk(bflo(o1v.z) + bflo(prv1.z), bfhi(o1v.z) + bfhi(prv1.z)); o1v.w = cvtpk(bflo(o1v.w) + bflo(prv1.w), bfhi(o1v.w) + bfhi(prv1.w));
            }
            if (!dry) { *(u32x4*)og0 = o0v; *(u32x4*)og1 = o1v; }
        }
    }
    __syncthreads();
#undef GLA_CHUNK
#undef GLA_ROW
#undef GLA_PREFETCH
}

constexpr int PP = 272;
__device__ __forceinline__ void pool_unit(LAS char* lds, int pm, int g, bf16_t* Z, const bf16_t* Wt  , const float* pscale, bool dry) {
    int tid = threadIdx.x; asm volatile("" : "+v"(tid)); const int lane = tid & 63, r32 = lane & 31, hi = lane >> 5; const int wid = __builtin_amdgcn_readfirstlane(tid >> 6);
    const int col = tid & 127, rq = tid >> 7;
    const int half = 1 << g;
    const int tiw = pm % 9; const int L = (tiw == 0) ? CTXL : SEQ; const int t0 = (tiw == 0) ? 0 : (tiw - 1) * 256;
    const bf16_t* ub = Z + (size_t)(pm * 256 - t0) * ZP + ZPX + g * 128;
    LAS char* U = lds + 256 * PP;
    {
        u32x4 uv[9];
#pragma unroll
        for (int k = 0; k < 9; ++k) { const int i = tid + 512 * k; const int j = i >> 4, ch = i & 15; const int t = t0 - 8 + j;
            uv[k] = (u32x4){0u, 0u, 0u, 0u}; if (i < 272 * 16 && t >= 0 && t < L) uv[k] = *(const u32x4*)(ub + (size_t)t * ZP + ch * 8); }
#pragma unroll
        for (int k = 0; k < 9; ++k) { const int i = tid + 512 * k; const int j = i >> 4, ch = i & 15;
            if (i < 272 * 16) *(LAS u32x4*)(U + j * PP + ch * 16) = uv[k]; }
    }
    __syncthreads();
    u32x4 wv[4];
#pragma unroll
    for (int k = 0; k < 4; ++k) { const int i = tid + 512 * k; wv[k] = *(const u32x4*)(Wt + (size_t)(i >> 4) * 128 + (i & 15) * 8); }
    {
        const int cg = tid & 31, rsg = tid >> 5;
        const LAS char* uc = U + cg * 8;
        const int ts = t0 + rsg * 16;
        int lo = ts - half; if (lo < 0) lo = 0; int hiw = ts + half; if (hiw > L) hiw = L;
        float s0 = 0.f, s1 = 0.f, s2 = 0.f, s3 = 0.f;
        for (int t = lo; t < hiw; ++t) { const u32x2 v = *(const LAS u32x2*)(uc + (t - t0 + 8) * PP); s0 += bflo(v.x); s1 += bfhi(v.x); s2 += bflo(v.y); s3 += bfhi(v.y); }
#pragma unroll 4
        for (int i = 0; i < 16; ++i) {
            const int t = ts + i;
            int l2 = t - half; if (l2 < 0) l2 = 0; int h2 = t + half; if (h2 > L) h2 = L;
            const u32x2 ut = *(const LAS u32x2*)(uc + (t - t0 + 8) * PP);
            const float rc = frcp((float)(h2 - l2));
            u32x2 w; w.x = cvtpk(s0 * rc - bflo(ut.x), s1 * rc - bfhi(ut.x)); w.y = cvtpk(s2 * rc - bflo(ut.y), s3 * rc - bfhi(ut.y));
            *(LAS u32x2*)(lds + (rsg * 16 + i) * PP + cg * 8) = w;
            if (t + half < L) { const u32x2 v = *(const LAS u32x2*)(uc + (t + half - t0 + 8) * PP); s0 += bflo(v.x); s1 += bfhi(v.x); s2 += bflo(v.y); s3 += bfhi(v.y); }
            if (t - half >= 0) { const u32x2 v = *(const LAS u32x2*)(uc + (t - half - t0 + 8) * PP); s0 -= bflo(v.x); s1 -= bfhi(v.x); s2 -= bflo(v.y); s3 -= bfhi(v.y); }
        }
    }
    __syncthreads();
#pragma unroll
    for (int k = 0; k < 4; ++k) { const int i = tid + 512 * k; *(LAS u32x4*)(U + (i >> 4) * PP + (i & 15) * 16) = wv[k]; }
    __syncthreads();
    f32x16 acc[4] = {};
#pragma unroll
    for (int s = 0; s < 8; ++s) {
        const bf16x8 a = *(const LAS bf16x8*)(lds + (32 * wid + r32) * PP + (16 * s + 8 * hi) * 2);
#pragma unroll
        for (int n = 0; n < 4; ++n) {
            const bf16x8 bw = *(const LAS bf16x8*)(U + (32 * n + r32) * PP + (16 * s + 8 * hi) * 2);
            acc[n] = __builtin_amdgcn_mfma_f32_32x32x16_bf16(a, bw, acc[n], 0, 0, 0);
        }
    }
#pragma unroll
    for (int n = 0; n < 4; ++n) { const float sc = pscale[g * 128 + 32 * n + r32];
#pragma unroll
        for (int r = 0; r < 16; ++r) ((LAS bf16_t*)lds)[(32 * wid + crow(r, hi)) * (PP / 2) + 32 * n + r32] = f2bf(acc[n][r] * sc); }
    asm volatile("s_waitcnt lgkmcnt(0)" ::: "memory");
#pragma unroll
    for (int i = 0; i < 8; ++i) { const int id = lane + 64 * i, row = id >> 4, ch = id & 15;
        const u32x4 ov = *(const LAS u32x4*)(lds + (32 * wid + row) * PP + ch * 16);
        bf16_t* yp = Z + (size_t)(pm * 256 + 32 * wid + row) * ZP + ZYP + g * 128 + ch * 8;
        if (!dry) { const u32x4 gv = *(const u32x4*)yp; u32x4 w;
            w.x = cvtpk(bflo(ov.x) * bflo(gv.x), bfhi(ov.x) * bfhi(gv.x)); w.y = cvtpk(bflo(ov.y) * bflo(gv.y), bfhi(ov.y) * bfhi(gv.y));
            w.z = cvtpk(bflo(ov.z) * bflo(gv.z), bfhi(ov.z) * bfhi(gv.z)); w.w = cvtpk(bflo(ov.w) * bflo(gv.w), bfhi(ov.w) * bfhi(gv.w));
            *(u32x4*)yp = w; } }
    __syncthreads();
}

__device__ __forceinline__ void prep_item(const Params& p, int l, int mat, int n, int kc, unsigned char* wl) {
    const int k0 = kc * 8; float v[8];
    bf16_t* dst;
    if (mat == 0) {
        dst = (bf16_t*)(wl + W_IN) + (size_t)n * 1024 + k0;
        int col = -1; float sg = 1.f;
        if (n < 256) col = C_MQ + n;
        else if (n < 512) { const int cc = n - 256;
            if (cc < 128) col = C_MKV + cc;
            else if (cc < 192) { const int c2 = cc - 128, g = c2 >> 3, nn = (c2 >> 2) & 1, j = c2 & 3, i = 4 * g + j;
                if (nn == 0) col = C_MKR + i; else { const int i16 = i & 15, base = i & 16; if (i16 < 8) { col = C_MKR + base + i16 + 8; sg = -1.f; } else col = C_MKR + base + i16 - 8; } }
            else if (cc < 208) col = C_AF + cc - 192;
            else if (cc < 224) col = C_AB + cc - 208; }
        else if (n < 1024) col = C_PX + n - 512;
        else if (n < 1280) col = C_GQ + n - 1024;
        else if (n < 1536) col = C_GK + n - 1280;
        else if (n < 2048) col = C_GV + n - 1536;
        else if (n < 2560) col = C_MG + n - 2048;
        else if (n < 3072) col = C_PG + n - 2560;
        else col = C_GG + n - 3072;
        const float* src = p.w_in + (size_t)l * D * DIN;
#pragma unroll
        for (int i = 0; i < 8; ++i) v[i] = (col >= 0) ? sg * src[(size_t)(k0 + i) * DIN + col] : 0.f;
    } else if (mat == 1) {
        dst = (bf16_t*)(wl + W_M) + (size_t)n * 1024 + k0;
        const float* src = p.w_in + (size_t)l * D * DIN + C_MRG + n;
#pragma unroll
        for (int i = 0; i < 8; ++i) v[i] = src[(size_t)(k0 + i) * DIN];
    } else if (mat == 2) {
        dst = (bf16_t*)(wl + W_UQ) + (size_t)n * 256 + k0;
        const int head = n >> 7, cc = n & 127; int col; float sg = 1.f;
        if (cc < 64) col = head * 96 + cc;
        else { const int c2 = cc - 64, g = c2 >> 3, nn = (c2 >> 2) & 1, j = c2 & 3, i = 4 * g + j;
            if (nn == 0) col = head * 96 + 64 + i; else { const int i16 = i & 15, base = i & 16; if (i16 < 8) { col = head * 96 + 64 + base + i16 + 8; sg = -1.f; } else col = head * 96 + 64 + base + i16 - 8; } }
        const float* src = p.mla_w_uq + (size_t)l * 256 * 768 + col; const float* gn = p.mla_q_norm + l * 256;
#pragma unroll
        for (int i = 0; i < 8; ++i) v[i] = sg * gn[k0 + i] * src[(size_t)(k0 + i) * 768];
    } else if (mat == 3) {
        dst = (bf16_t*)(wl + W_UKV) + (size_t)n * 256 + k0;
        const int col = (n < 512) ? ((n >> 6) * 128 + (n & 63)) : (((n - 512) >> 6) * 128 + 64 + (n & 63));
        const float* src = p.mla_w_ukv + (size_t)l * 128 * 1024 + col; const float* gn = p.mla_kv_norm + l * 128;
#pragma unroll
        for (int i = 0; i < 8; ++i) v[i] = (k0 < 128) ? gn[k0 + i] * src[(size_t)(k0 + i) * 1024] : 0.f;
    } else if (mat == 4) {
        dst = (bf16_t*)(wl + W_BR) + (size_t)n * 1536 + k0;
        const int br = k0 >> 9, kk = k0 & 511;
        const float* src = (br == 0 ? p.w_bm : (br == 1 ? p.w_bp : p.w_bg)) + (size_t)l * 512 * 1024 + n;
#pragma unroll
        for (int i = 0; i < 8; ++i) v[i] = src[(size_t)(kk + i) * 1024];
    } else if (mat == 5) {
        dst = (bf16_t*)(wl + W_OUT) + (size_t)n * 1024 + k0;
        const float* src = p.w_out + (size_t)l * 1024 * 1024 + n;
#pragma unroll
        for (int i = 0; i < 8; ++i) v[i] = src[(size_t)(k0 + i) * 1024];
    } else {
        dst = (bf16_t*)(wl + W_POOL) + (size_t)n * 128 + k0;
        const int g = n >> 7, o = n & 127;
        const float* src = p.pool_w + (size_t)l * 4 * 128 * 128 + (size_t)g * 128 * 128 + o;
#pragma unroll
        for (int i = 0; i < 8; ++i) v[i] = src[(size_t)(k0 + i) * 128];
    }
    u32x4 o; o.x = cvtpk(v[0], v[1]); o.y = cvtpk(v[2], v[3]); o.z = cvtpk(v[4], v[5]); o.w = cvtpk(v[6], v[7]);
    *(u32x4*)dst = o;
}

__device__ __forceinline__ void modnorm_row(const float* xr, const float* pre_g, const float* modrow, bf16_t* hrow, int l32) {
    f32x4 v[8]; float s = 0.f;
#pragma unroll
    for (int j = 0; j < 4; ++j) { v[2 * j] = *(const f32x4*)(xr + 8 * l32 + 256 * j); v[2 * j + 1] = *(const f32x4*)(xr + 8 * l32 + 256 * j + 4); }
#pragma unroll
    for (int j = 0; j < 8; ++j) s += v[j][0] * v[j][0] + v[j][1] * v[j][1] + v[j][2] * v[j][2] + v[j][3] * v[j][3];
#pragma unroll
    for (int o = 1; o < 32; o <<= 1) s += __shfl_xor(s, o);
    const float rs = __builtin_amdgcn_rsqf(s * (1.f / D) + EPS);
#pragma unroll
    for (int j = 0; j < 4; ++j) { float o[8];
#pragma unroll
        for (int q = 0; q < 2; ++q) { const int c = 8 * l32 + 256 * j + 4 * q;
            const f32x4 g = *(const f32x4*)(pre_g + c), sh = *(const f32x4*)(modrow + c), sc = *(const f32x4*)(modrow + D + c);
#pragma unroll
            for (int e = 0; e < 4; ++e) o[4 * q + e] = v[2 * j + q][e] * rs * g[e] * (1.f + sc[e]) + sh[e]; }
        u32x4 pk; pk.x = cvtpk(o[0], o[1]); pk.y = cvtpk(o[2], o[3]); pk.z = cvtpk(o[4], o[5]); pk.w = cvtpk(o[6], o[7]);
        *(u32x4*)(hrow + 8 * l32 + 256 * j) = pk; }
}

__global__ void __launch_bounds__(512, 2) fwd_kernel(Params p) {
    extern __shared__ __attribute__((aligned(16))) unsigned char lds_raw[];
    LAS unsigned char* lds = (LAS unsigned char*)lds_raw;
    cg::grid_group grid = cg::this_grid();
    const int wid = __builtin_amdgcn_readfirstlane(threadIdx.x >> 6);
    const int G = gridDim.x, bid = blockIdx.x;
    const int vcu = (G % 8 == 0) ? (bid % 8) * (G / 8) + bid / 8 : bid;
    const int gw = bid * 8 + wid, NGW = G * 8;
    unsigned char* ws = p.ws;
    bf16_t* Z = (bf16_t*)(ws + OFF_Z); bf16_t* H = (bf16_t*)(ws + OFF_H); bf16_t* Qb = (bf16_t*)(ws + OFF_Q); bf16_t* KVb = (bf16_t*)(ws + OFF_KV);
    bf16_t* OT = (bf16_t*)(ws + OFF_OT); bf16_t* KR = (bf16_t*)(ws + OFF_KR);
    float* ssq_q = (float*)(ws + OFF_SSQQ); float* ssq_kv = (float*)(ws + OFF_SSQKV); float* modb = (float*)(ws + OFF_MOD); f32x2* tab = (f32x2*)(ws + OFF_TAB);
    const int lo = p.ph_lo, hi_ph = p.ph_hi; const bool dryflag = (p.ph_lo == 0);
    unsigned* barw = (unsigned*)(ws + OFF_BAR);
    XcdBarrier xbar; xbar.bar = barw; xbar.x = 0; xbar.st = (volatile LAS unsigned*)(lds + 147200);
    if (threadIdx.x < 2) ((volatile LAS unsigned*)(lds + 147200))[threadIdx.x] = 0u;
    if (bid == 0) for (int i = threadIdx.x; i < XCD_BAR_WORDS; i += 512) barw[i] = 0u;
    int ph = 0;
#define PHASE_BEGIN if (ph >= lo && ph < hi_ph) { int tid = threadIdx.x; asm volatile("" : "+v"(tid)); const int lane = tid & 63; (void)lane;
#define PHASE_END } ++ph; if (ph > lo && ph < hi_ph) { if (ph == 1) { grid.sync(); xbar = xcd_barrier_post(barw, (volatile LAS unsigned*)(lds + 147200)); } else { xcd_barrier(xbar); if (DUP == 12) { xcd_barrier(xbar); xcd_barrier(xbar); xcd_barrier(xbar); xcd_barrier(xbar); } } }

    PHASE_BEGIN
    for (int rep = (DUP == 10 ? 0 : 1); rep < 2; ++rep) {
        const long gt = (long)bid * 512 + tid, NT = (long)G * 512;
        for (int l = 0; l < 2; ++l) {
            unsigned char* wl = ws + OFF_W + (size_t)l * W_LAYER;
            for (long it = gt; it < 3584L * 128; it += NT) prep_item(p, l, 0, (int)(it % 3584), (int)(it / 3584), wl);
            for (long it = gt; it < 3072L * 128; it += NT) prep_item(p, l, 1, (int)(it % 3072), (int)(it / 3072), wl);
            for (long it = gt; it < 1024L * 32; it += NT) prep_item(p, l, 2, (int)(it % 1024), (int)(it / 1024), wl);
            for (long it = gt; it < 1024L * 32; it += NT) prep_item(p, l, 3, (int)(it % 1024), (int)(it / 1024), wl);
            for (long it = gt; it < 1024L * 192; it += NT) prep_item(p, l, 4, (int)(it % 1024), (int)(it / 1024), wl);
            for (long it = gt; it < 1024L * 128; it += NT) prep_item(p, l, 5, (int)(it % 1024), (int)(it / 1024), wl);
            for (long it = gt; it < 512L * 16; it += NT) prep_item(p, l, 6, (int)(it % 512), (int)(it / 512), wl);
        }
        if (gt < 512) { const int pos = (int)gt >> 3, f = (int)gt & 7; const float inv = exp2f(-(float)f * (13.287712379549449f / 8.f));
            const float rev = (float)pos * inv * 0.15915494309189535f; const float fr_ = rev - floorf(rev);
            f32x2 e; e.x = __builtin_amdgcn_cosf(fr_); e.y = __builtin_amdgcn_sinf(fr_); tab[gt] = e; }
        for (long i = gt; i < M; i += NT) { ssq_q[i] = 0.f; ssq_kv[i] = 0.f; }
        LAS float* sc = (LAS float*)lds;
        for (int i = tid; i < 33 * 1024; i += 512) { const int bb = i >> 10, k = i & 1023; const float cv = (bb < 32) ? p.c[bb * 1024 + k] : p.c_ctx[k]; sc[i] = cv / (1.f + __expf(-cv)); }
        __syncthreads();
        for (int u = bid; u < 192; u += G) {
            const int l = u / 96, cgp = u % 96; const int colq = tid & 31, kg = tid >> 5;
            float a[33];
#pragma unroll
            for (int bb = 0; bb < 33; ++bb) a[bb] = 0.f;
            const float* wp = p.mod_w + (size_t)l * 1024 * 3072 + cgp * 32 + colq;
            for (int k0 = kg * 64; k0 < kg * 64 + 64; k0 += 8) { float w8[8];
#pragma unroll
                for (int q = 0; q < 8; ++q) w8[q] = wp[(size_t)(k0 + q) * 3072];
#pragma unroll
                for (int q = 0; q < 8; ++q)
#pragma unroll
                    for (int bb = 0; bb < 33; ++bb) a[bb] += sc[bb * 1024 + k0 + q] * w8[q]; }
            LAS float* red = (LAS float*)(lds + 135168);
            for (int i = tid; i < 33 * 32; i += 512) red[i] = 0.f;
            __syncthreads();
#pragma unroll
            for (int bb = 0; bb < 33; ++bb) atomicAdd((float*)(red + bb * 32 + colq), a[bb]);
            __syncthreads();
            for (int i = tid; i < 33 * 32; i += 512) { const int bb = i >> 5, cq = i & 31; modb[((size_t)l * 33 + bb) * 3072 + cgp * 32 + cq] = red[i] + p.mod_b[l * 3072 + cgp * 32 + cq]; }
            __syncthreads();
        }
    }
    PHASE_END

    PHASE_BEGIN
    for (int rep = (DUP == 9 ? 0 : 1); rep < 2; ++rep)
    for (int r0 = 2 * gw; r0 < M; r0 += 2 * NGW) { const int r = r0 + (lane >> 5);
        const int b = r / TOK, tok = r % TOK;
        const float* xr = (tok < CTXL) ? p.ctx + ((size_t)b * CTXL + tok) * D : p.x + ((size_t)b * SEQ + tok - CTXL) * D;
        modnorm_row(xr, p.pre_norm, modb + (size_t)((tok < CTXL) ? 32 : b) * 3072, H + (size_t)r * D, lane & 31);
    }
    PHASE_END

    for (int l = 0; l < 2; ++l) {
        unsigned char* wl = ws + OFF_W + (size_t)l * W_LAYER;
        GEpi E; E.Z = Z; E.KR = KR; E.ssq_q = ssq_q; E.ssq_kv = ssq_kv; E.Qb = Qb; E.KVb = KVb; E.gscr = ws + OFF_Q + (size_t)bid * GSCR_PER_WG; E.tab = tab;
        GSched S; S.G = G; S.c = bid; S.Z = (const char*)Z; S.H = (const char*)H; S.W = (const char*)wl;

        PHASE_BEGIN
        S.mode = 0; S.latent_only = (l == 1);
        if (DUP == 1) gemm_phase(lds, S, E, dryflag);
        gemm_phase(lds, S, E, false);
        PHASE_END

        PHASE_BEGIN
        for (int rep = (DUP == 2 ? 0 : 1); rep < 2; ++rep)
        for (int u = vcu; u < 256; u += G) {
            const int b = u >> 3, h = (u >> 1) & 3, dvh = u & 1;
            gla_unit((LAS char*)lds, b, h, dvh, Z, OT, p.af_w2 + l * 16 * 256, p.af_b + l * 256, p.ab_w2 + l * 16 * 256, p.ab_b + l * 256, rep == 0 && dryflag);
        }
        __syncthreads();
        S.mode = 1; S.latent_only = (l == 1);
        if (DUP == 3) gemm_phase(lds, S, E, dryflag);
        gemm_phase(lds, S, E, false);
        for (int rep = (DUP == 4 ? 0 : 1); rep < 2; ++rep)
        for (int u = vcu; u < 288 * 4; u += G) { const int pm = u >> 2, g = u & 3;
            if (l == 1 && pm % 9 == 0) continue;
            pool_unit((LAS char*)lds, pm, g, Z, (const bf16_t*)(wl + W_POOL) + (size_t)g * 128 * 128, p.pool_scale + l * 512, rep == 0 && dryflag); }
        PHASE_END

        PHASE_BEGIN
        for (int rep = (DUP == 11 ? 0 : 1); rep < 2; ++rep)
        for (int r0 = 4 * gw; r0 < M; r0 += 4 * NGW) {
            if (l == 1 && (r0 % TOK) < CTXL) continue;
            const int r = r0 + (lane >> 4), l16 = lane & 15;
            u32x4 ov[4], gv[4];
#pragma unroll
            for (int hh = 0; hh < 4; ++hh) { ov[hh] = *(const u32x4*)(OT + (size_t)r * 512 + hh * 128 + 8 * l16); gv[hh] = *(const u32x4*)(Z + (size_t)r * ZP + ZYG + hh * 128 + 8 * l16); }
            const f32x4 gn0 = *(const f32x4*)(p.gla_norm + l * 128 + 8 * l16), gn1 = *(const f32x4*)(p.gla_norm + l * 128 + 8 * l16 + 4);
#pragma unroll
            for (int hh = 0; hh < 4; ++hh) {
                float o[8] = {bflo(ov[hh].x), bfhi(ov[hh].x), bflo(ov[hh].y), bfhi(ov[hh].y), bflo(ov[hh].z), bfhi(ov[hh].z), bflo(ov[hh].w), bfhi(ov[hh].w)};
                float s = 0.f;
#pragma unroll
                for (int j = 0; j < 8; ++j) s += o[j] * o[j];
                s += __shfl_xor(s, 1); s += __shfl_xor(s, 2); s += __shfl_xor(s, 4); s += __shfl_xor(s, 8);
                const float rs = __builtin_amdgcn_rsqf(s * (1.f / 128.f) + EPS);
                const float gt[8] = {bflo(gv[hh].x), bfhi(gv[hh].x), bflo(gv[hh].y), bfhi(gv[hh].y), bflo(gv[hh].z), bfhi(gv[hh].z), bflo(gv[hh].w), bfhi(gv[hh].w)};
                u32x4 ow; ow.x = cvtpk(o[0] * rs * gn0[0] * gt[0], o[1] * rs * gn0[1] * gt[1]); ow.y = cvtpk(o[2] * rs * gn0[2] * gt[2], o[3] * rs * gn0[3] * gt[3]);
                ow.z = cvtpk(o[4] * rs * gn1[0] * gt[4], o[5] * rs * gn1[1] * gt[5]); ow.w = cvtpk(o[6] * rs * gn1[2] * gt[6], o[7] * rs * gn1[3] * gt[7]);
                if (!(rep == 0 && dryflag)) *(u32x4*)(Z + (size_t)r * ZP + ZYG + hh * 128 + 8 * l16) = ow;
            }
        }
        __syncthreads();
        {
            const int nlat = 2048, nctx = (l == 0) ? 256 : 0;
            for (int rep = (DUP == 5 ? 0 : 1); rep < 2; ++rep)
            for (int u = vcu; u < nlat + nctx; u += G) { const bool dry = (rep == 0) && dryflag;
                if (u < nlat) { const int bh = u >> 3, qb = u & 7, b = bh >> 3, h = bh & 7; const size_t q0 = (size_t)b * TOK + CTXL + qb * 256, k0 = (size_t)b * TOK;
                    attn_unit((LAS char*)lds, Qb + q0 * 768 + h * 96, KVb + k0 * 1024 + h * 64, KR + k0 * 32, 36, Z + q0 * ZP + ZYM + h * 64, dry); }
                else { const int bh = u - nlat, b = bh >> 3, h = bh & 7; const size_t q0 = (size_t)b * TOK;
                    attn_unit((LAS char*)lds, Qb + q0 * 768 + h * 96, KVb + q0 * 1024 + h * 64, KR + q0 * 32, 4, Z + q0 * ZP + ZYM + h * 64, dry); }
            }
        }
        PHASE_END

        PHASE_BEGIN
        S.mode = 2; S.latent_only = (l == 1);
        if (DUP == 6) gemm_phase(lds, S, E, dryflag);
        if (DUP == 13) gemm_phase(lds, S, E, !dryflag);
        gemm_phase(lds, S, E, false);
        PHASE_END

        PHASE_BEGIN
        S.mode = 3; S.latent_only = (l == 1);
        if (DUP == 7) gemm_phase(lds, S, E, dryflag);
        gemm_phase(lds, S, E, false);
        PHASE_END

        PHASE_BEGIN
        for (int rep = (DUP == 8 ? 0 : 1); rep < 2; ++rep)
        for (int r0 = 2 * gw; r0 < M; r0 += 2 * NGW) { const bool dry = (rep == 0) && dryflag;
            const int l32 = lane & 31; const int r = r0 + (lane >> 5);
            const int b = r / TOK, tok = r % TOK; const bool isctx = tok < CTXL;
            if (l == 1 && (r0 % TOK) < CTXL) continue;
            const bf16_t* orow = Z + (size_t)r * ZP + 1024;
            const float* xr = (l == 0) ? (isctx ? p.ctx + ((size_t)b * CTXL + tok) * D : p.x + ((size_t)b * SEQ + tok - CTXL) * D) : p.out + ((size_t)b * SEQ + tok - CTXL) * D;
            const float* mrow = modb + ((size_t)l * 33 + (isctx ? 32 : b)) * 3072;
            u32x4 t4[4]; f32x4 xv[8];
#pragma unroll
            for (int j = 0; j < 4; ++j) { t4[j] = *(const u32x4*)(orow + 8 * l32 + 256 * j); xv[2 * j] = *(const f32x4*)(xr + 8 * l32 + 256 * j); xv[2 * j + 1] = *(const f32x4*)(xr + 8 * l32 + 256 * j + 4); }
            float ov[32]; float s = 0.f;
#pragma unroll
            for (int j = 0; j < 4; ++j) {
                ov[8 * j + 0] = bflo(t4[j].x); ov[8 * j + 1] = bfhi(t4[j].x); ov[8 * j + 2] = bflo(t4[j].y); ov[8 * j + 3] = bfhi(t4[j].y); ov[8 * j + 4] = bflo(t4[j].z); ov[8 * j + 5] = bfhi(t4[j].z); ov[8 * j + 6] = bflo(t4[j].w); ov[8 * j + 7] = bfhi(t4[j].w); }
#pragma unroll
            for (int j = 0; j < 32; ++j) s += ov[j] * ov[j];
#pragma unroll
            for (int o = 1; o < 32; o <<= 1) s += __shfl_xor(s, o);
            const float rs = __builtin_amdgcn_rsqf(s * (1.f / D) + EPS);
            float s2 = 0.f;
#pragma unroll
            for (int j = 0; j < 4; ++j)
#pragma unroll
                for (int q = 0; q < 2; ++q) { const int c = 8 * l32 + 256 * j + 4 * q;
                    const f32x4 pg = *(const f32x4*)(p.post_norm + l * D + c), gt = *(const f32x4*)(mrow + 2 * D + c);
#pragma unroll
                    for (int e = 0; e < 4; ++e) { const float v = xv[2 * j + q][e] + gt[e] * ov[8 * j + 4 * q + e] * rs * pg[e]; ov[8 * j + 4 * q + e] = v; s2 += v * v; } }
            if (!isctx && !dry) { float* orw = p.out + ((size_t)b * SEQ + tok - CTXL) * D;
#pragma unroll
                for (int j = 0; j < 4; ++j)
#pragma unroll
                    for (int q = 0; q < 2; ++q) *(f32x4*)(orw + 8 * l32 + 256 * j + 4 * q) = (f32x4){ov[8 * j + 4 * q], ov[8 * j + 4 * q + 1], ov[8 * j + 4 * q + 2], ov[8 * j + 4 * q + 3]}; }
            if (l == 0) {
#pragma unroll
                for (int o = 1; o < 32; o <<= 1) s2 += __shfl_xor(s2, o);
                if (!dry) {
                const float rs2 = __builtin_amdgcn_rsqf(s2 * (1.f / D) + EPS);
                const float* m1 = modb + ((size_t)33 + (isctx ? 32 : b)) * 3072;
#pragma unroll
                for (int j = 0; j < 4; ++j) { float hv[8];
#pragma unroll
                    for (int q = 0; q < 2; ++q) { const int c = 8 * l32 + 256 * j + 4 * q;
                        const f32x4 g = *(const f32x4*)(p.pre_norm + D + c), sh = *(const f32x4*)(m1 + c), scl = *(const f32x4*)(m1 + D + c);
#pragma unroll
                        for (int e = 0; e < 4; ++e) hv[4 * q + e] = ov[8 * j + 4 * q + e] * rs2 * g[e] * (1.f + scl[e]) + sh[e]; }
                    u32x4 hw; hw.x = cvtpk(hv[0], hv[1]); hw.y = cvtpk(hv[2], hv[3]); hw.z = cvtpk(hv[4], hv[5]); hw.w = cvtpk(hv[6], hv[7]);
                    *(u32x4*)(H + (size_t)r * D + 8 * l32 + 256 * j) = hw; }
                if (l32 == 0) { ssq_q[r] = 0.f; ssq_kv[r] = 0.f; }
                }
            }
        }
        PHASE_END
    }
}

extern "C" void kernel_launch(void* const* d_in, const int* in_sizes, int n_in, void* d_out, int out_size, void* d_ws, size_t ws_size, hipStream_t stream) {
    static int grid = 0;
    if (grid == 0) {
        if (n_in != 24 || ws_size < WS_END) { fprintf(stderr, "kernel_launch: bad inputs n_in=%d ws=%zu need %zu\n", n_in, ws_size, (size_t)WS_END); grid = -1; return; }
        int dev = 0, cus = 0, per_cu = 0;
        hipGetDevice(&dev); hipDeviceGetAttribute(&cus, hipDeviceAttributeMultiprocessorCount, dev);
        hipFuncSetAttribute((const void*)fwd_kernel, hipFuncAttributeMaxDynamicSharedMemorySize, LDS_BYTES);
        hipOccupancyMaxActiveBlocksPerMultiprocessor(&per_cu, (const void*)fwd_kernel, 512, LDS_BYTES);
        if (per_cu < 1) { fprintf(stderr, "kernel_launch: occupancy query returned %d\n", per_cu); per_cu = 1; }
        (void)hipGetLastError();
        grid = cus < 256 ? cus : 256;
    }
    if (grid < 0) return;
    Params p{};
    const float** f = (const float**)&p;
    for (int i = 0; i < 24; ++i) f[i] = (const float*)d_in[i];
    p.out = (float*)d_out; p.ws = (unsigned char*)d_ws; p.ph_lo = 0; p.ph_hi = 1000;
    void* args[] = {&p};
    hipError_t e = hipLaunchCooperativeKernel((const void*)fwd_kernel, dim3(grid), dim3(512), args, LDS_BYTES, stream);
    if (e != hipSuccess) fprintf(stderr, "cooperative launch failed: %s (grid %d)\n", hipGetErrorString(e), grid);
}
```
